# Optimizing an MI355X kernel written in HIP

```python
import math
import jax, jax.numpy as jnp
from jax import lax
import numpy as np


D_MODEL = 1024
BATCH = 8
SEQ = 4096
DEPTH = 1

CHUNK = 64
Q_BLOCK = 128
MEM_LEN = 256

DA_HEADS = 4
DA_HEAD_DIM = 64
DA_QK_WIDTH = DA_HEADS * 2 * DA_HEAD_DIM
DA_V_WIDTH = DA_HEADS * 2 * DA_HEAD_DIM

GLA_HEADS = 4
GLA_DK = 64
GLA_DV = 128
GLA_K_WIDTH = GLA_HEADS * GLA_DK
GLA_V_WIDTH = GLA_HEADS * GLA_DV
GLA_GATE_RANK = 16
GLA_GATE_NORM = 16.0

IN_SIZES = (DA_QK_WIDTH, DA_QK_WIDTH, DA_V_WIDTH,
            GLA_K_WIDTH, GLA_K_WIDTH, GLA_V_WIDTH, GLA_V_WIDTH, GLA_GATE_RANK)
IN_WIDTH = sum(IN_SIZES)
MIX_WIDTH = DA_V_WIDTH + GLA_V_WIDTH

FFN_HIDDEN = 2816
CROSS_HEADS = 4
CROSS_HEAD_DIM = D_MODEL // CROSS_HEADS

ALPHA = (2.0 * DEPTH) ** 0.25
BETA = (8.0 * DEPTH) ** -0.25
EPS = 1e-5

kernel_name = 'hymba_diffattn_gla_macaron_deepnorm'


def layer_norm(x, g, b):
    xf = x.astype(jnp.float32)
    mu = jnp.mean(xf, axis=-1, keepdims=True)
    var = jnp.mean(jnp.square(xf - mu), axis=-1, keepdims=True)
    y = (xf - mu) * lax.rsqrt(var + EPS)
    return (y * g.astype(jnp.float32) + b.astype(jnp.float32)).astype(x.dtype)


def rms_norm(x, g):
    xf = x.astype(jnp.float32)
    y = xf * lax.rsqrt(jnp.mean(jnp.square(xf), axis=-1, keepdims=True) + EPS)
    return (y * g.astype(jnp.float32)).astype(x.dtype)


def swiglu(x, w_gate, w_up, w_down):
    return (jax.nn.silu(x @ w_gate) * (x @ w_up)) @ w_down


def diff_attention(q, k, v, lam):
    B, S, H, _, d = q.shape
    n_qb = S // Q_BLOCK
    scale = DA_HEAD_DIM ** -0.5
    q_blocks = (q * scale).reshape(B, n_qb, Q_BLOCK, H, 2, d).transpose(1, 0, 3, 4, 2, 5)
    k_t = k.transpose(0, 2, 3, 1, 4)
    v_t = v.transpose(0, 2, 1, 3)
    key_chunk = jnp.arange(S) // CHUNK
    starts = jnp.arange(n_qb) * Q_BLOCK

    def one_block(args):
        q_blk, start = args
        s = jnp.einsum('bhcqd,bhckd->bhcqk', q_blk, k_t).astype(jnp.float32)
        q_chunk = (start + jnp.arange(Q_BLOCK)) // CHUNK
        mask = key_chunk[None, :] <= q_chunk[:, None]
        p = jax.nn.softmax(jnp.where(mask, s, -jnp.inf), axis=-1)
        w = p[:, :, 0] - lam * p[:, :, 1]
        return jnp.einsum('bhqk,bhkv->bhqv', w.astype(v_t.dtype), v_t)

    o = lax.map(one_block, (q_blocks, starts))
    return o.transpose(1, 0, 3, 2, 4).reshape(B, S, H, 2 * d)


def gla_chunk_causal(q, k, v, log_a):
    B, S, H, dk = q.shape
    dv = v.shape[-1]
    n_c = S // CHUNK
    qc = q.reshape(B, n_c, CHUNK, H, dk).astype(jnp.float32)
    kc = k.reshape(B, n_c, CHUNK, H, dk).astype(jnp.float32)
    vc = v.reshape(B, n_c, CHUNK, H, dv).astype(jnp.float32)
    cum = jnp.cumsum(log_a.reshape(B, n_c, CHUNK, H, dk).astype(jnp.float32), axis=2)
    total = cum[:, :, -1]
    k_end = kc * jnp.exp(total[:, :, None] - cum)
    d_state = jnp.einsum('bnchk,bnchv->nbhkv', k_end, vc)
    decay = jnp.exp(total).transpose(1, 0, 2, 3)

    def step(s_prev, inp):
        dec, ds = inp
        s_new = dec[..., None] * s_prev + ds
        return s_new, s_new

    _, states = lax.scan(step, jnp.zeros((B, H, dk, dv), jnp.float32), (decay, d_state))
    o = jnp.einsum('bnchk,nbhkv->bnchv', qc * (GLA_DK ** -0.5), states)
    return o.reshape(B, S, H, dv)


def memory_cross_attention(h, mem, w_q, w_kv, w_o):
    B, S, _ = h.shape
    M = mem.shape[1]
    q = (h @ w_q).reshape(B, S, CROSS_HEADS, CROSS_HEAD_DIM)
    k, v = jnp.split(mem @ w_kv, 2, axis=-1)
    k = k.reshape(B, M, CROSS_HEADS, CROSS_HEAD_DIM)
    v = v.reshape(B, M, CROSS_HEADS, CROSS_HEAD_DIM)
    s = jnp.einsum('bshd,bmhd->bhsm', q, k).astype(jnp.float32) * (CROSS_HEAD_DIM ** -0.5)
    p = jax.nn.softmax(s, axis=-1).astype(v.dtype)
    o = jnp.einsum('bhsm,bmhd->bshd', p, v).reshape(B, S, D_MODEL)
    return o @ w_o


def setup_inputs(seed: int = 0) -> dict:
    key = jax.random.key(seed)
    ks = iter(jax.random.split(key, 32))

    def nrm(shape, scale):
        return jax.random.normal(next(ks), shape, jnp.float32) * scale

    def gain(n):
        return 1.0 + nrm((DEPTH, n), 0.02)

    L, D, F = DEPTH, D_MODEL, FFN_HIDDEN
    return {
        'x': nrm((BATCH, SEQ, D), 1.0),
        'mem': nrm((BATCH, MEM_LEN, D), 1.0),
        'ffn1_w_gate': nrm((L, D, F), D ** -0.5),
        'ffn1_w_up': nrm((L, D, F), D ** -0.5),
        'ffn1_w_down': nrm((L, F, D), BETA * F ** -0.5),
        'ln1_g': gain(D),
        'ln1_b': nrm((L, D), 0.02),
        'w_in': nrm((L, D, IN_WIDTH), D ** -0.5),
        'da_lambda_q1': nrm((L, DA_HEAD_DIM), 0.1),
        'da_lambda_k1': nrm((L, DA_HEAD_DIM), 0.1),
        'da_lambda_q2': nrm((L, DA_HEAD_DIM), 0.1),
        'da_lambda_k2': nrm((L, DA_HEAD_DIM), 0.1),
        'da_norm_g': gain(2 * DA_HEAD_DIM),
        'gla_w_gate2': nrm((L, GLA_GATE_RANK, GLA_K_WIDTH), GLA_GATE_RANK ** -0.5),
        'gla_b_gate': nrm((L, GLA_K_WIDTH), 0.02),
        'gla_norm_g': gain(GLA_DV),
        'w_out': nrm((L, MIX_WIDTH, D), BETA * MIX_WIDTH ** -0.5),
        'ln2_g': gain(D),
        'ln2_b': nrm((L, D), 0.02),
        'cross_wq': nrm((L, D, D), D ** -0.5),
        'cross_wkv': nrm((L, D, 2 * D), D ** -0.5),
        'cross_wo': nrm((L, D, D), BETA * D ** -0.5),
        'ln3_g': gain(D),
        'ln3_b': nrm((L, D), 0.02),
        'ffn2_w_gate': nrm((L, D, F), D ** -0.5),
        'ffn2_w_up': nrm((L, D, F), D ** -0.5),
        'ffn2_w_down': nrm((L, F, D), BETA * F ** -0.5),
        'ln4_g': gain(D),
        'ln4_b': nrm((L, D), 0.02),
    }


def reference(x, mem, ffn1_w_gate, ffn1_w_up, ffn1_w_down, ln1_g, ln1_b, w_in,
              da_lambda_q1, da_lambda_k1, da_lambda_q2, da_lambda_k2, da_norm_g,
              gla_w_gate2, gla_b_gate, gla_norm_g, w_out, ln2_g, ln2_b,
              cross_wq, cross_wkv, cross_wo, ln3_g, ln3_b,
              ffn2_w_gate, ffn2_w_up, ffn2_w_down, ln4_g, ln4_b):
    B, S, _ = x.shape
    split_points = [int(i) for i in np.cumsum(IN_SIZES)[:-1]]
    h = x
    for l in range(DEPTH):
        h = layer_norm(ALPHA * h + 0.5 * swiglu(h, ffn1_w_gate[l], ffn1_w_up[l], ffn1_w_down[l]),
                       ln1_g[l], ln1_b[l])

        q_da, k_da, v_da, q_g, k_g, v_g, r_g, g_lr = jnp.split(h @ w_in[l], split_points, axis=-1)

        lambda_init = 0.8 - 0.6 * math.exp(-0.3 * l)
        lam = (jnp.exp(jnp.sum(da_lambda_q1[l].astype(jnp.float32) * da_lambda_k1[l].astype(jnp.float32)))
               - jnp.exp(jnp.sum(da_lambda_q2[l].astype(jnp.float32) * da_lambda_k2[l].astype(jnp.float32)))
               + lambda_init)
        o_da = diff_attention(q_da.reshape(B, S, DA_HEADS, 2, DA_HEAD_DIM),
                              k_da.reshape(B, S, DA_HEADS, 2, DA_HEAD_DIM),
                              v_da.reshape(B, S, DA_HEADS, 2 * DA_HEAD_DIM), lam)
        o_da = rms_norm(o_da, da_norm_g[l]) * (1.0 - lambda_init)

        log_a = jax.nn.log_sigmoid((g_lr @ gla_w_gate2[l] + gla_b_gate[l]).astype(jnp.float32)) / GLA_GATE_NORM
        o_g = gla_chunk_causal(q_g.reshape(B, S, GLA_HEADS, GLA_DK),
                               k_g.reshape(B, S, GLA_HEADS, GLA_DK),
                               v_g.reshape(B, S, GLA_HEADS, GLA_DV),
                               log_a.reshape(B, S, GLA_HEADS, GLA_DK))
        o_g = rms_norm(o_g.astype(x.dtype), gla_norm_g[l]) * jax.nn.silu(r_g).reshape(B, S, GLA_HEADS, GLA_DV)

        mix = jnp.concatenate([o_da.reshape(B, S, DA_V_WIDTH).astype(x.dtype),
                               o_g.reshape(B, S, GLA_V_WIDTH).astype(x.dtype)], axis=-1) @ w_out[l]
        h = layer_norm(ALPHA * h + mix, ln2_g[l], ln2_b[l])

        c = memory_cross_attention(h, mem, cross_wq[l], cross_wkv[l], cross_wo[l])
        h = layer_norm(ALPHA * h + c, ln3_g[l], ln3_b[l])

        h = layer_norm(ALPHA * h + 0.5 * swiglu(h, ffn2_w_gate[l], ffn2_w_up[l], ffn2_w_down[l]),
                       ln4_g[l], ln4_b[l])
    return h
```

```cpp
#include <hip/hip_runtime.h>
#include <hip/hip_cooperative_groups.h>
#include <cstdio>
#include <cstdint>
#include <cmath>
namespace cg = cooperative_groups;

namespace pg8 {
#define PG8_LAS __attribute__((address_space(3)))
typedef unsigned short bf16_t;
typedef short bf16x8 __attribute__((ext_vector_type(8)));
typedef float f32x4 __attribute__((ext_vector_type(4)));
typedef unsigned u32x4 __attribute__((ext_vector_type(4)));
constexpr int BM = 256, BK = 64, HALF = 128, HTB = HALF * BK * 2  , STAGE_BYTES = 8 * HTB, NXCD = 8, WGM = 8;

__host__ __device__ __forceinline__ int lds_byte(int r, int c) { const int st = (r >> 4) * 2 + (c >> 5), rr = r & 15, cc = c & 31, ob = rr * 64 + cc * 2; return st * 1024 + (ob ^ (((ob >> 9) & 1) << 5)); }
__host__ __device__ __forceinline__ void stage_rc(int b, int& R, int& C) { const int st = b / 1024, sb = b % 1024, swz = sb ^ (((sb >> 9) & 1) << 5); R = (st >> 1) * 16 + swz / 64; C = (st & 1) * 32 + (swz % 64) / 2; }
__host__ __device__ __forceinline__ int perm32(int rho) { const int n = rho >> 4, i = rho & 15; return 8 * (i >> 2) + 4 * n + (i & 3); }

struct Unit { int pm, pn; };
struct Gemm { const bf16_t* A; const bf16_t* Bt; int M, N, K; };

struct StaticOrder {
    int nM, nN, nwg, G, c;
    __host__ __device__ void init(int M, int N, int G_, int c_) { nM = M / BM; nN = N / BM; nwg = nM * nN; G = G_; c = c_; }
    __host__ __device__ bool next(int i, Unit& u) const {
        const long L = (long)i * G + c; if (L >= nwg) return false;
        int wgid = (int)L; { const int q = nwg / NXCD, r = nwg % NXCD, xcd = wgid % NXCD, off = wgid / NXCD; wgid = (xcd < r ? xcd * (q + 1) : r * (q + 1) + (xcd - r) * q) + off; }
        const int nig = WGM * nN, gid = wgid / nig, fm = gid * WGM, gsz = (nM - fm) < WGM ? (nM - fm) : WGM;
        u.pm = fm + ((wgid % nig) % gsz); u.pn = (wgid % nig) / gsz; return true;
    }
    __device__ __forceinline__ void a_ready(const Unit&) const {}
    __device__ __forceinline__ void done(const Unit&) const {}
};

__device__ __forceinline__ unsigned cvt_pk_bf16(float lo, float hi) { unsigned r; asm volatile("v_cvt_pk_bf16_f32 %0, %1, %2" : "=v"(r) : "v"(lo), "v"(hi)); return r; }

struct EpiStore {
    static constexpr bool PERM = true, AFTER_DRAIN = false;
    bf16_t* O; int ldc; int nscale; float scale0;
    __device__ __forceinline__ void operator()(const f32x4 (&acc)[2][2][4][2], const Unit& u, int wr, int wc, int fr, int fq) const {
        const int row0 = u.pm * BM + wr * 64 + fr, col0 = u.pn * BM + wc * 32 + 8 * fq;
        const float sc = (u.pn < nscale) ? scale0 : 1.f;
#pragma unroll
        for (int ai = 0; ai < 2; ++ai)
#pragma unroll
            for (int m = 0; m < 4; ++m) { bf16_t* rowp = O + (size_t)(row0 + ai * HALF + m * 16) * ldc + col0;
#pragma unroll
                for (int bj = 0; bj < 2; ++bj) { const f32x4 v0 = acc[ai][bj][m][0] * sc, v1 = acc[ai][bj][m][1] * sc;
                    u32x4 w; w.x = cvt_pk_bf16(v0[0], v0[1]); w.y = cvt_pk_bf16(v0[2], v0[3]); w.z = cvt_pk_bf16(v1[0], v1[1]); w.w = cvt_pk_bf16(v1[2], v1[3]);
                    *(u32x4*)(rowp + bj * HALF) = w; } }
    }
};
__device__ __forceinline__ float silu_f(float g) { return g * __builtin_amdgcn_rcpf(1.f + __builtin_amdgcn_exp2f(-1.4426950408889634f * g)); }
struct EpiSwiglu {
    static constexpr bool PERM = true, AFTER_DRAIN = false;
    bf16_t* O; int ldc;
    __device__ __forceinline__ void operator()(const f32x4 (&acc)[2][2][4][2], const Unit& u, int wr, int wc, int fr, int fq) const {
        const int row0 = u.pm * BM + wr * 64 + fr, col0 = u.pn * HALF + wc * 32 + 8 * fq;
#pragma unroll
        for (int ai = 0; ai < 2; ++ai)
#pragma unroll
            for (int m = 0; m < 4; ++m) { bf16_t* rowp = O + (size_t)(row0 + ai * HALF + m * 16) * ldc + col0;
                float h[8];
#pragma unroll
                for (int n = 0; n < 2; ++n)
#pragma unroll
                    for (int j = 0; j < 4; ++j) h[n * 4 + j] = silu_f(acc[ai][0][m][n][j]) * acc[ai][1][m][n][j];
                u32x4 w; w.x = cvt_pk_bf16(h[0], h[1]); w.y = cvt_pk_bf16(h[2], h[3]); w.z = cvt_pk_bf16(h[4], h[5]); w.w = cvt_pk_bf16(h[6], h[7]);
                *(u32x4*)rowp = w; }
    }
};
template <int MODE> struct EpiResid {
    static constexpr bool PERM = false, AFTER_DRAIN = false;
    float* V; const float* X; const float* stats; const float* g; const float* b; int ldc; float alpha, scale;
    __device__ __forceinline__ void operator()(const f32x4 (&acc)[2][2][4][2], const Unit& u, int wr, int wc, int fr, int fq) const {
        const int row0 = u.pm * BM + wr * 64 + fr, col0 = u.pn * BM + wc * 32 + 4 * fq;
#pragma unroll
        for (int ai = 0; ai < 2; ++ai)
#pragma unroll
            for (int m = 0; m < 4; ++m) { const int row = row0 + ai * HALF + m * 16; const size_t off = (size_t)row * ldc + col0;
                float mean = 0.f, rstd = 1.f;
                if (MODE == 1) { mean = stats[2 * row]; rstd = stats[2 * row + 1]; }
#pragma unroll
                for (int bj = 0; bj < 2; ++bj)
#pragma unroll
                    for (int n = 0; n < 2; ++n) {
                        f32x4 r;
                        if (MODE == 0) r = *(const f32x4*)(X + off + bj * HALF + n * 16);
                        else { const f32x4 v = *(const f32x4*)(V + off + bj * HALF + n * 16); const f32x4 gv = *(const f32x4*)(g + col0 + bj * HALF + n * 16), bv = *(const f32x4*)(b + col0 + bj * HALF + n * 16); r = (v - mean) * rstd * gv + bv; }
                        *(f32x4*)(V + off + bj * HALF + n * 16) = r * alpha + acc[ai][bj][m][n] * scale; }
                asm volatile("" ::: "memory"); }
    }
};

constexpr float LNEPS = 1e-5f;
__device__ __forceinline__ float pg_xor16(float v) { return __int_as_float(__builtin_amdgcn_ds_swizzle(__float_as_int(v), 0x1F | (16 << 10))); }
__device__ __forceinline__ float pg_half_sum(float v) { auto rr = __builtin_amdgcn_permlane32_swap(__float_as_uint(v), __float_as_uint(v), false, false); return __uint_as_float(rr[0]) + __uint_as_float(rr[1]); }
__device__ __forceinline__ void row_stats(const float* __restrict__ PST, int row, float& mean, float& rstd) {
    const f32x4 a = *(const f32x4*)(PST + (size_t)row * 8), b = *(const f32x4*)(PST + (size_t)row * 8 + 4);
    const float s = (a.x + a.z) + (b.x + b.z), q = (a.y + a.w) + (b.y + b.w);
    mean = s * (1.f / 1024.f); const float var = fmaxf(q * (1.f / 1024.f) - mean * mean, 0.f); rstd = 1.f / sqrtf(var + LNEPS);
}
struct StatsOrder : StaticOrder {
    const float* PST; PG8_LAS unsigned char* sbuf; int by_pn; const float* cs; const float* bw; PG8_LAS unsigned char* cbuf; mutable int k;
    __device__ __forceinline__ void a_ready(const Unit& u) const {
        const int tid = threadIdx.x, wid = __builtin_amdgcn_readfirstlane(tid >> 6);
        const float* gp = PST + (size_t)((by_pn ? u.pn : u.pm) * BM + (tid >> 1)) * 8 + (tid & 1) * 4;
        __builtin_amdgcn_global_load_lds((const unsigned*)gp, (PG8_LAS unsigned*)(sbuf + (k & 1) * 8192 + wid * 1024), 16, 0, 0);
        if (cs != nullptr && wid < 2) {
            const float* cp = (wid == 0 ? cs : bw) + (by_pn ? u.pm : u.pn) * BM + (tid & 63) * 4;
            __builtin_amdgcn_global_load_lds((const unsigned*)cp, (PG8_LAS unsigned*)(cbuf + (k & 1) * 2048 + wid * 1024), 16, 0, 0);
        }
        ++k;
    }
};
__device__ __forceinline__ void row_stats_lds(const PG8_LAS float* sb, int rl, float& mean, float& rstd) {
    const f32x4 a = *(const PG8_LAS f32x4*)(sb + rl * 8), b = *(const PG8_LAS f32x4*)(sb + rl * 8 + 4);
    const float s = (a.x + a.z) + (b.x + b.z), q = (a.y + a.w) + (b.y + b.w);
    mean = s * (1.f / 1024.f); const float var = fmaxf(q * (1.f / 1024.f) - mean * mean, 0.f); rstd = __builtin_amdgcn_rsqf(var + LNEPS);
}
struct EpiStoreLn {
    static constexpr bool PERM = true, AFTER_DRAIN = false;
    bf16_t* O; int ldc; int nscale; float scale0; const PG8_LAS float* sbuf; const PG8_LAS float* cbuf; mutable int k;
    __device__ __forceinline__ void operator()(const f32x4 (&acc)[2][2][4][2], const Unit& u, int wr, int wc, int fr, int fq) const {
        const int row0 = u.pm * BM + wr * 64 + fr, col0 = u.pn * BM + wc * 32 + 8 * fq;
        const PG8_LAS float* sb = sbuf + (k & 1) * 2048; const PG8_LAS float* cb = cbuf + (k & 1) * 512 + wc * 32 + 8 * fq; ++k;
        const float sc = (u.pn < nscale) ? scale0 : 1.f;
        f32x4 c4[2][2], b4[2][2];
#pragma unroll
        for (int bj = 0; bj < 2; ++bj)
#pragma unroll
            for (int n = 0; n < 2; ++n) { c4[bj][n] = *(const PG8_LAS f32x4*)(cb + bj * HALF + 4 * n); b4[bj][n] = *(const PG8_LAS f32x4*)(cb + 256 + bj * HALF + 4 * n); }
#pragma unroll
        for (int ai = 0; ai < 2; ++ai)
#pragma unroll
            for (int m = 0; m < 4; ++m) { const int row = row0 + ai * HALF + m * 16; bf16_t* rowp = O + (size_t)row * ldc + col0;
                float mean, rstd; row_stats_lds(sb, ai * HALF + wr * 64 + m * 16 + fr, mean, rstd); const float mr = mean * rstd;
#pragma unroll
                for (int bj = 0; bj < 2; ++bj) { const f32x4 v0 = (acc[ai][bj][m][0] * rstd - c4[bj][0] * mr + b4[bj][0]) * sc, v1 = (acc[ai][bj][m][1] * rstd - c4[bj][1] * mr + b4[bj][1]) * sc;
                    u32x4 w; w.x = cvt_pk_bf16(v0[0], v0[1]); w.y = cvt_pk_bf16(v0[2], v0[3]); w.z = cvt_pk_bf16(v1[0], v1[1]); w.w = cvt_pk_bf16(v1[2], v1[3]);
                    *(u32x4*)(rowp + bj * HALF) = w; } }
    }
};
struct EpiStoreLnT {
    static constexpr bool PERM = true, AFTER_DRAIN = false;
    bf16_t* O; int ldc; const PG8_LAS float* sbuf; const PG8_LAS float* cbuf; mutable int k;
    __device__ __forceinline__ void operator()(const f32x4 (&acc)[2][2][4][2], const Unit& u, int wr, int wc, int fr, int fq) const {
        const int row0 = u.pm * BM + wr * 64 + fr, col0 = u.pn * BM + wc * 32 + 8 * fq;
        const PG8_LAS float* sb = sbuf + (k & 1) * 2048; const PG8_LAS float* cb = cbuf + (k & 1) * 512 + wr * 64 + fr; ++k;
        float tr[2][8], tmr[2][8];
#pragma unroll
        for (int bj = 0; bj < 2; ++bj)
#pragma unroll
            for (int e = 0; e < 8; ++e) { float mean, rstd; row_stats_lds(sb, wc * 32 + 8 * fq + bj * HALF + e, mean, rstd); tr[bj][e] = rstd; tmr[bj][e] = mean * rstd; }
#pragma unroll
        for (int ai = 0; ai < 2; ++ai)
#pragma unroll
            for (int m = 0; m < 4; ++m) { const int row = row0 + ai * HALF + m * 16; bf16_t* rowp = O + (size_t)row * ldc + col0; const float c = cb[ai * HALF + m * 16], b = cb[256 + ai * HALF + m * 16];
#pragma unroll
                for (int bj = 0; bj < 2; ++bj) { float v[8];
#pragma unroll
                    for (int e = 0; e < 8; ++e) v[e] = acc[ai][bj][m][e >> 2][e & 3] * tr[bj][e] - c * tmr[bj][e] + b;
                    u32x4 w; w.x = cvt_pk_bf16(v[0], v[1]); w.y = cvt_pk_bf16(v[2], v[3]); w.z = cvt_pk_bf16(v[4], v[5]); w.w = cvt_pk_bf16(v[6], v[7]);
                    *(u32x4*)(rowp + bj * HALF) = w; } }
    }
};
struct EpiSwigluLn {
    static constexpr bool PERM = true, AFTER_DRAIN = false;
    bf16_t* O; int ldc; const PG8_LAS float* sbuf; const PG8_LAS float* cbuf; mutable int k;
    __device__ __forceinline__ void operator()(const f32x4 (&acc)[2][2][4][2], const Unit& u, int wr, int wc, int fr, int fq) const {
        const int row0 = u.pm * BM + wr * 64 + fr, col0 = u.pn * HALF + wc * 32 + 8 * fq;
        const PG8_LAS float* sb = sbuf + (k & 1) * 2048; const PG8_LAS float* cb = cbuf + (k & 1) * 512 + wc * 32 + 8 * fq; ++k;
        f32x4 c4[2][2], b4[2][2];
#pragma unroll
        for (int bj = 0; bj < 2; ++bj)
#pragma unroll
            for (int n = 0; n < 2; ++n) { c4[bj][n] = *(const PG8_LAS f32x4*)(cb + bj * HALF + 4 * n); b4[bj][n] = *(const PG8_LAS f32x4*)(cb + 256 + bj * HALF + 4 * n); }
#pragma unroll
        for (int ai = 0; ai < 2; ++ai)
#pragma unroll
            for (int m = 0; m < 4; ++m) { const int row = row0 + ai * HALF + m * 16; bf16_t* rowp = O + (size_t)row * ldc + col0;
                float mean, rstd; row_stats_lds(sb, ai * HALF + wr * 64 + m * 16 + fr, mean, rstd); const float mr = mean * rstd;
                float h[8];
#pragma unroll
                for (int n = 0; n < 2; ++n) { const f32x4 gt = acc[ai][0][m][n] * rstd - c4[0][n] * mr + b4[0][n], up = acc[ai][1][m][n] * rstd - c4[1][n] * mr + b4[1][n];
#pragma unroll
                    for (int j = 0; j < 4; ++j) h[n * 4 + j] = silu_f(gt[j]) * up[j]; }
                u32x4 w; w.x = cvt_pk_bf16(h[0], h[1]); w.y = cvt_pk_bf16(h[2], h[3]); w.z = cvt_pk_bf16(h[4], h[5]); w.w = cvt_pk_bf16(h[6], h[7]);
                *(u32x4*)rowp = w; }
    }
};
template <int MODE, bool STATS> struct EpiResidS {
    static constexpr bool PERM = false, AFTER_DRAIN = false;
    float* V; const bf16_t* RB; const PG8_LAS float* sbuf; const float* g; const float* b; bf16_t* VB; float* PSTout; PG8_LAS float* red; int ldc; float alpha, scale; mutable int k;
    __device__ __forceinline__ void operator()(const f32x4 (&acc)[2][2][4][2], const Unit& u, int wr, int wc, int fr, int fq) const {
        typedef unsigned u32x2 __attribute__((ext_vector_type(2)));
        const int row0 = u.pm * BM + wr * 64 + fr, col0 = u.pn * BM + wc * 32 + 4 * fq;
        const PG8_LAS float* sb = sbuf + (k & 1) * 2048; ++k;
#pragma unroll
        for (int ai = 0; ai < 2; ++ai) {
            u32x2 rv[4][2][2];
#pragma unroll
            for (int m = 0; m < 4; ++m) { const unsigned off = (unsigned)((row0 + ai * HALF + m * 16) * ldc + col0);
#pragma unroll
                for (int bj = 0; bj < 2; ++bj)
#pragma unroll
                    for (int n = 0; n < 2; ++n) rv[m][bj][n] = *(const u32x2*)(RB + off + bj * HALF + n * 16); }
            f32x4 gv[2][2], bv[2][2];
            if (MODE == 1) {
#pragma unroll
                for (int bj = 0; bj < 2; ++bj)
#pragma unroll
                    for (int n = 0; n < 2; ++n) { gv[bj][n] = *(const f32x4*)(g + col0 + bj * HALF + n * 16); bv[bj][n] = *(const f32x4*)(b + col0 + bj * HALF + n * 16); }
            }
#pragma unroll
            for (int m = 0; m < 4; ++m) { const unsigned off = (unsigned)((row0 + ai * HALF + m * 16) * ldc + col0);
                float mean = 0.f, rstd = 1.f;
                if (MODE == 1) row_stats_lds(sb, ai * HALF + wr * 64 + m * 16 + fr, mean, rstd);
                float s = 0.f, q = 0.f;
#pragma unroll
                for (int bj = 0; bj < 2; ++bj)
#pragma unroll
                    for (int n = 0; n < 2; ++n) {
                        const u32x2 rw = rv[m][bj][n];
                        f32x4 r = {__uint_as_float(rw.x << 16), __uint_as_float(rw.x & 0xffff0000u), __uint_as_float(rw.y << 16), __uint_as_float(rw.y & 0xffff0000u)};
                        if (MODE == 1) r = (r - mean) * rstd * gv[bj][n] + bv[bj][n];
                        const f32x4 o = r * alpha + acc[ai][bj][m][n] * scale;
                        if (STATS) { s += (o[0] + o[1]) + (o[2] + o[3]); q += (o[0] * o[0] + o[1] * o[1]) + (o[2] * o[2] + o[3] * o[3]);
                            u32x2 w; w.x = cvt_pk_bf16(o[0], o[1]); w.y = cvt_pk_bf16(o[2], o[3]); *(u32x2*)(VB + off + bj * HALF + n * 16) = w; }
                        else *(f32x4*)(V + off + bj * HALF + n * 16) = o; }
                if (STATS) { s += pg_xor16(s); q += pg_xor16(q); s = pg_half_sum(s); q = pg_half_sum(q);
                    if (fq == 0) { PG8_LAS float* rp = red + (ai * HALF + wr * 64 + m * 16 + fr) * 8 + wc * 2; rp[0] = s; rp[1] = q; } } }
            asm volatile("" ::: "memory");
        }
        if (STATS) {
            asm volatile("s_waitcnt lgkmcnt(0)" ::: "memory"); __builtin_amdgcn_s_barrier(); asm volatile("" ::: "memory");
            const int t = (wr * 4 + wc) * 64 + fq * 16 + fr, rl = t >> 1, wh = t & 1;
            const PG8_LAS float* rp = red + rl * 8 + wh;
            PSTout[(size_t)(u.pm * BM + rl) * 8 + u.pn * 2 + wh] = (rp[0] + rp[2]) + (rp[4] + rp[6]);
        }
    }
};

template <class Epi, class Sched, bool ALIGN_EPI = false, bool SP2 = false>
__device__ __forceinline__ void gemm_phase(PG8_LAS unsigned char* lds, const Gemm g, const Sched& S, const Epi& E) {
    int tid_ = threadIdx.x; asm volatile("" : "+v"(tid_));
    const int tid = tid_, wid = __builtin_amdgcn_readfirstlane(tid >> 6), lane = tid & 63, wr = wid >> 2, wc = wid & 3, fr = lane & 15, fq = lane >> 4;
    const int K = g.K, nt = K / BK;
    unsigned voffA[2], voffB[2];
#pragma unroll
    for (int i = 0; i < 2; ++i) { int R, C; stage_rc(tid * 16 + i * 8192, R, C); const int Rb = Epi::PERM ? ((R & ~31) + perm32(R & 31)) : R;
        voffA[i] = (unsigned)(R * K + C) * 2u; voffB[i] = (unsigned)(Rb * K + C) * 2u; }
    const size_t kstep = (size_t)(BK * 2);
    const size_t hstep = (size_t)HALF * K * 2;
    const size_t tstep = 2 * hstep;
    const unsigned ldsw = (unsigned)wid * 1024u;
    const int aoff = lds_byte(wr * 64 + fr, fq * 8), boff = lds_byte(wc * 32 + fr, fq * 8);
#define PG8_SA(b, h) (((b) * 2 + (h)) * HTB)
#define PG8_SB(b, h) ((4 + (b) * 2 + (h)) * HTB)
#define PG8_STAGE(bufoff, gbase, voff) do { _Pragma("unroll") for (int _i = 0; _i < 2; ++_i) \
        __builtin_amdgcn_global_load_lds((const unsigned*)((const char*)(gbase) + (voff)[_i]), (PG8_LAS unsigned*)(lds + (bufoff) + ldsw + _i * 8192), 16, 0, 0); } while (0)
#define PG8_LDA(dst, b, h) do { _Pragma("unroll") for (int m = 0; m < 4; ++m) _Pragma("unroll") for (int k = 0; k < 2; ++k) dst[m][k] = *(const PG8_LAS bf16x8*)(lds + PG8_SA(b, h) + aoff + m * 2048 + k * 1024); } while (0)
#define PG8_LDB(dst, b, h) do { _Pragma("unroll") for (int n = 0; n < 2; ++n) _Pragma("unroll") for (int k = 0; k < 2; ++k) dst[n][k] = *(const PG8_LAS bf16x8*)(lds + PG8_SB(b, h) + boff + n * 2048 + k * 1024); } while (0)
#define PG8_MMA(ai, bj, At, Bt) do { __builtin_amdgcn_s_setprio(1); _Pragma("unroll") for (int m = 0; m < 4; ++m) _Pragma("unroll") for (int n = 0; n < 2; ++n) _Pragma("unroll") for (int k = 0; k < 2; ++k) \
        acc[ai][bj][m][n] = __builtin_amdgcn_mfma_f32_16x16x32_bf16(Bt[n][k], At[m][k], acc[ai][bj][m][n], 0, 0, 0); __builtin_amdgcn_s_setprio(0); } while (0)
#define PG8_WAIT_V(n) asm volatile("s_waitcnt vmcnt(" #n ")" ::: "memory")
#define PG8_WAIT_L(n) asm volatile("s_waitcnt lgkmcnt(" #n ")" ::: "memory")
#define PG8_BAR __builtin_amdgcn_s_barrier()
#define PG8_SCHED __builtin_amdgcn_sched_barrier(0)
    Unit cur, nxt; int ui = 0;
    if (!S.next(0, cur)) return;
    f32x4 acc[2][2][4][2];
#pragma unroll
    for (int a = 0; a < 2; ++a)
#pragma unroll
        for (int b = 0; b < 2; ++b)
#pragma unroll
            for (int m = 0; m < 4; ++m)
#pragma unroll
                for (int n = 0; n < 2; ++n) acc[a][b][m][n] = (f32x4){0.f, 0.f, 0.f, 0.f};
    bf16x8 At[4][2], B0[2][2], B1[2][2];
    const char* cA = (const char*)g.A + (size_t)cur.pm * tstep; const char* cB = (const char*)g.Bt + (size_t)cur.pn * tstep;
    S.a_ready(cur);
    if constexpr (SP2) {
        PG8_STAGE(PG8_SB(0, 0), cB, voffB); PG8_STAGE(PG8_SB(0, 1), cB + hstep, voffB); PG8_STAGE(PG8_SA(0, 0), cA, voffA); PG8_STAGE(PG8_SA(0, 1), cA + hstep, voffA);
        if (wr == 1) PG8_BAR;
        PG8_WAIT_V(2); PG8_BAR;
        PG8_STAGE(PG8_SB(1, 0), cB + kstep, voffB); PG8_STAGE(PG8_SA(1, 0), cA + kstep, voffA); PG8_STAGE(PG8_SB(1, 1), cB + hstep + kstep, voffB);
        PG8_WAIT_V(6); PG8_BAR;
    } else {
        PG8_STAGE(PG8_SB(0, 0), cB, voffB); PG8_STAGE(PG8_SA(0, 0), cA, voffA); PG8_STAGE(PG8_SB(0, 1), cB + hstep, voffB); PG8_STAGE(PG8_SA(0, 1), cA + hstep, voffA);
        if (wr == 1) PG8_BAR;
        PG8_WAIT_V(4); PG8_BAR;
        PG8_STAGE(PG8_SB(1, 0), cB + kstep, voffB); PG8_STAGE(PG8_SA(1, 0), cA + kstep, voffA); PG8_STAGE(PG8_SB(1, 1), cB + hstep + kstep, voffB);
        PG8_WAIT_V(6); PG8_BAR;
    }
    for (;;) {
        const bool has_next = S.next(ui + 1, nxt);
        const char* nA = has_next ? (const char*)g.A + (size_t)nxt.pm * tstep : cA; const char* nB = has_next ? (const char*)g.Bt + (size_t)nxt.pn * tstep : cB;
        for (int t = 0; t < nt; t += 2) {
            const bool last = (t == nt - 2);
            const char* a1 = cA + (size_t)(t + 1) * kstep;
            const char* a2 = last ? nA : cA + (size_t)(t + 2) * kstep; const char* b2 = last ? nB : cB + (size_t)(t + 2) * kstep;
            const char* a3 = a2 + kstep; const char* b3 = b2 + kstep;
            if (last && has_next) S.a_ready(nxt);
            if constexpr (SP2) {
            PG8_LDB(B0, 0, 0); PG8_LDB(B1, 0, 1); PG8_SCHED; PG8_LDA(At, 0, 0); PG8_STAGE(PG8_SA(1, 1), a1 + hstep, voffA);
            PG8_WAIT_V(8); PG8_WAIT_L(0); PG8_BAR; PG8_MMA(0, 0, At, B0); PG8_MMA(0, 1, At, B1); PG8_BAR; PG8_SCHED;
            PG8_LDA(At, 0, 1); PG8_STAGE(PG8_SB(0, 0), b2, voffB); PG8_STAGE(PG8_SB(0, 1), b2 + hstep, voffB); PG8_STAGE(PG8_SA(0, 0), a2, voffA);
            PG8_WAIT_V(8); PG8_WAIT_L(0); PG8_BAR; PG8_MMA(1, 0, At, B0); PG8_MMA(1, 1, At, B1); PG8_BAR; PG8_SCHED;
            PG8_LDB(B0, 1, 0); PG8_LDB(B1, 1, 1); PG8_SCHED; PG8_LDA(At, 1, 0); PG8_STAGE(PG8_SA(0, 1), a2 + hstep, voffA);
            PG8_WAIT_V(8); PG8_WAIT_L(0); PG8_BAR; PG8_MMA(0, 0, At, B0); PG8_MMA(0, 1, At, B1); PG8_BAR; PG8_SCHED;
            PG8_LDA(At, 1, 1); PG8_STAGE(PG8_SB(1, 0), b3, voffB); PG8_STAGE(PG8_SB(1, 1), b3 + hstep, voffB); PG8_STAGE(PG8_SA(1, 0), a3, voffA);
            PG8_WAIT_V(8); PG8_WAIT_L(0); PG8_BAR; PG8_MMA(1, 0, At, B0); PG8_MMA(1, 1, At, B1); PG8_BAR; PG8_SCHED;
            } else {
            PG8_LDB(B0, 0, 0); PG8_SCHED; PG8_LDA(At, 0, 0); PG8_STAGE(PG8_SA(1, 1), a1 + hstep, voffA);
            PG8_WAIT_L(8); PG8_BAR; PG8_WAIT_L(0); PG8_MMA(0, 0, At, B0); PG8_BAR; PG8_SCHED;
            PG8_LDB(B1, 0, 1); PG8_STAGE(PG8_SB(0, 0), b2, voffB);
            PG8_BAR; PG8_WAIT_L(0); PG8_MMA(0, 1, At, B1); PG8_BAR;
            PG8_LDA(At, 0, 1); PG8_STAGE(PG8_SA(0, 0), a2, voffA);
            PG8_BAR; PG8_WAIT_L(0); PG8_MMA(1, 0, At, B0); PG8_BAR; PG8_SCHED;
            PG8_STAGE(PG8_SB(0, 1), b2 + hstep, voffB);
            PG8_WAIT_V(6); PG8_BAR; PG8_MMA(1, 1, At, B1); PG8_BAR;
            PG8_LDB(B0, 1, 0); PG8_SCHED; PG8_LDA(At, 1, 0); PG8_STAGE(PG8_SA(0, 1), a2 + hstep, voffA);
            PG8_WAIT_L(8); PG8_BAR; PG8_WAIT_L(0); PG8_MMA(0, 0, At, B0); PG8_BAR; PG8_SCHED;
            PG8_LDB(B1, 1, 1); PG8_STAGE(PG8_SB(1, 0), b3, voffB);
            PG8_BAR; PG8_WAIT_L(0); PG8_MMA(0, 1, At, B1); PG8_BAR;
            PG8_LDA(At, 1, 1); PG8_STAGE(PG8_SA(1, 0), a3, voffA);
            PG8_BAR; PG8_WAIT_L(0); PG8_MMA(1, 0, At, B0); PG8_BAR; PG8_SCHED;
            PG8_STAGE(PG8_SB(1, 1), b3 + hstep, voffB);
            PG8_WAIT_V(6); PG8_BAR; PG8_MMA(1, 1, At, B1); PG8_BAR;
            }
        }
        if constexpr (ALIGN_EPI) { if (wr == 0) PG8_BAR; }
        if constexpr (!Epi::AFTER_DRAIN) { E(acc, cur, wr, wc, fr, fq); S.done(cur); }
        if (!has_next) break;
#pragma unroll
        for (int a = 0; a < 2; ++a)
#pragma unroll
            for (int b = 0; b < 2; ++b)
#pragma unroll
                for (int m = 0; m < 4; ++m)
#pragma unroll
                    for (int n = 0; n < 2; ++n) acc[a][b][m][n] = (f32x4){0.f, 0.f, 0.f, 0.f};
        cur = nxt; cA = nA; cB = nB; ++ui;
        if constexpr (ALIGN_EPI) { if (wr == 1) PG8_BAR; }
    }
    PG8_WAIT_V(0);
    if constexpr (!ALIGN_EPI) { if (wr == 0) PG8_BAR; }
    PG8_BAR;
    if constexpr (Epi::AFTER_DRAIN) { E.fused(acc, cur, wr, wc, fr, fq, lds, wid, lane); S.done(cur); }
#undef PG8_SA
#undef PG8_SB
#undef PG8_STAGE
#undef PG8_LDA
#undef PG8_LDB
#undef PG8_MMA
#undef PG8_WAIT_V
#undef PG8_WAIT_L
#undef PG8_BAR
#undef PG8_SCHED
}
}
constexpr int D = 1024, BATCH = 8, SEQ = 4096, T = BATCH * SEQ, FH = 2816, MEM = 256, TM = BATCH * MEM;
constexpr int NIN = 2816;
constexpr int QD = 0, KD = 512, QG = 1024, KG = 1280, VG = 1536, RG = 2048, GL = 2560;
constexpr int WIN_ROWS = 3328, VDROW = 2816;
constexpr float ALPHA = 1.189207115002721f;
constexpr float LN_EPS = 1e-5f;
constexpr float LOG2E = 1.4426950408889634f;
constexpr float C2_DA = 0.125f * LOG2E;
constexpr float C2_X = 0.0625f * LOG2E;
constexpr float LAMBDA_INIT = 0.2f;

constexpr size_t MiB = 1u << 20;
constexpr size_t WS_GU1 = 0, WS_D1 = 11 * MiB, WS_WIN = 17 * MiB, WS_WOUT = 24 * MiB, WS_WQ = 26 * MiB, WS_WKV = 28 * MiB, WS_WO = 32 * MiB, WS_GU2 = 34 * MiB, WS_D2 = 45 * MiB;
constexpr size_t WS_MB = 51 * MiB, WS_KVC = 55 * MiB, WS_STATS = 63 * MiB;
constexpr size_t WS_XB = 64 * MiB;
constexpr size_t WS_HB = 128 * MiB;
constexpr size_t WS_R1 = 192 * MiB;
constexpr size_t WS_DS = 400 * MiB;
constexpr size_t WS_DEC = 464 * MiB;
constexpr size_t WS_VT = 465 * MiB;
constexpr size_t WS_CTL = 497 * MiB;
constexpr size_t WS_PSTA = 498 * MiB, WS_PSTB = 499 * MiB;
constexpr size_t WS_PARTC = 500 * MiB, WS_PARTB = 501 * MiB;
constexpr size_t WS_CS = 502 * MiB, WS_BW = 502 * MiB + 512 * 1024;
constexpr size_t WS_END = 503 * MiB;
constexpr int LDS_BYTES = 157696;

typedef unsigned short bf16;
typedef unsigned v4u __attribute__((ext_vector_type(4)));
typedef unsigned v2u __attribute__((ext_vector_type(2)));
typedef float f32x4 __attribute__((ext_vector_type(4)));
#define LAS __attribute__((address_space(3)))

__device__ __forceinline__ unsigned f2bf(float f) { unsigned u = __builtin_bit_cast(unsigned, f); return (u + 0x7fffu + ((u >> 16) & 1u)) >> 16; }
__device__ __forceinline__ unsigned pk2(float lo, float hi) { return f2bf(lo) | (f2bf(hi) << 16); }
__device__ __forceinline__ float bf2f(bf16 u) { return __uint_as_float((unsigned)u << 16); }
__device__ __forceinline__ float bflo(unsigned w) { return __uint_as_float(w << 16); }
__device__ __forceinline__ float bfhi(unsigned w) { return __uint_as_float(w & 0xffff0000u); }
template <int O> __device__ __forceinline__ float swz_xor(float v) { return __int_as_float(__builtin_amdgcn_ds_swizzle(__float_as_int(v), 0x1F | (O << 10))); }
__device__ __forceinline__ float half_sum(float v) { auto rr = __builtin_amdgcn_permlane32_swap(__float_as_uint(v), __float_as_uint(v), false, false); return __uint_as_float(rr[0]) + __uint_as_float(rr[1]); }
__device__ __forceinline__ float half_max(float v) { auto rr = __builtin_amdgcn_permlane32_swap(__float_as_uint(v), __float_as_uint(v), false, false); return fmaxf(__uint_as_float(rr[0]), __uint_as_float(rr[1])); }
__device__ __forceinline__ float sum32(float v) { v += swz_xor<1>(v); v += swz_xor<2>(v); v += swz_xor<4>(v); v += swz_xor<8>(v); v += swz_xor<16>(v); return v; }
__device__ __forceinline__ float wave_sum(float v) { return half_sum(sum32(v)); }
__device__ __forceinline__ float wave_max(float v) { v = fmaxf(v, swz_xor<1>(v)); v = fmaxf(v, swz_xor<2>(v)); v = fmaxf(v, swz_xor<4>(v)); v = fmaxf(v, swz_xor<8>(v)); v = fmaxf(v, swz_xor<16>(v)); return half_max(v); }

constexpr int PTOT = 9984, WIN_OFF = 0, WQ_OFF = 3328, GU2_OFF = 4352;
template <bool FOLD> __device__ __forceinline__ void transpose_item(const float* __restrict__ W, int K, int N, bf16* __restrict__ WT, int k0, int n0, int drow0, float* scr, int lane,
                                                                    const float* __restrict__ g, const float* __restrict__ b, float* __restrict__ PC, float* __restrict__ PB) {
    const int nq = 4 * (lane & 15), kr = lane >> 4; const bool ok = (n0 + nq) < N;
    f32x4 v[16];
#pragma unroll
    for (int i = 0; i < 16; ++i) v[i] = ok ? *(const f32x4*)(W + (size_t)(k0 + kr + 4 * i) * N + n0 + nq) : (f32x4){0.f, 0.f, 0.f, 0.f};
#pragma unroll
    for (int i = 0; i < 16; ++i) { float* d = scr + (kr + 4 * i) * 65 + nq; d[0] = v[i].x; d[1] = v[i].y; d[2] = v[i].z; d[3] = v[i].w; }
    __builtin_amdgcn_wave_barrier(); asm volatile("s_waitcnt lgkmcnt(0)" ::: "memory");
    const int c = lane & 7;
    float gk[8], bk[8];
    if (FOLD) {
#pragma unroll
        for (int e = 0; e < 8; ++e) { gk[e] = g[k0 + 8 * c + e]; bk[e] = b[k0 + 8 * c + e]; }
    }
#pragma unroll
    for (int j = 0; j < 8; ++j) { const int n = (lane >> 3) + 8 * j; const float* s = scr + (8 * c) * 65 + n;
        float x[8];
#pragma unroll
        for (int e = 0; e < 8; ++e) x[e] = s[e * 65];
        v4u o;
        if (FOLD) {
            float ws = 0.f, bs = 0.f; unsigned h[8];
#pragma unroll
            for (int e = 0; e < 8; ++e) { h[e] = f2bf(x[e] * gk[e]); ws += __uint_as_float(h[e] << 16); bs += bk[e] * x[e]; }
            o.x = h[0] | (h[1] << 16); o.y = h[2] | (h[3] << 16); o.z = h[4] | (h[5] << 16); o.w = h[6] | (h[7] << 16);
            ws += swz_xor<1>(ws); ws += swz_xor<2>(ws); ws += swz_xor<4>(ws); bs += swz_xor<1>(bs); bs += swz_xor<2>(bs); bs += swz_xor<4>(bs);
            if (c == 0) { const size_t pi = (size_t)(k0 >> 6) * PTOT + drow0 + n; PC[pi] = ws; PB[pi] = bs; }
        } else { o.x = pk2(x[0], x[1]); o.y = pk2(x[2], x[3]); o.z = pk2(x[4], x[5]); o.w = pk2(x[6], x[7]); }
        *(v4u*)(WT + (size_t)(drow0 + n) * K + k0 + 8 * c) = o; }
    __builtin_amdgcn_wave_barrier(); asm volatile("s_waitcnt lgkmcnt(0)" ::: "memory");
}
template <int MAP, bool FOLD> __device__ __forceinline__ void transpose_matrix(const float* W, int K, int N, bf16* WT, float* scr, int gw, int NGW, int lane,
                                                                               const float* g = nullptr, const float* b = nullptr, float* PC = nullptr, float* PB = nullptr) {
    const int nblk = (N + 63) / 64, items = (K / 64) * nblk;
    for (int it = gw; it < items; it += NGW) { const int kb = it / nblk, nb = it % nblk, n0 = 64 * nb;
        int drow0 = n0;
        if (MAP == 1 || MAP == 2) drow0 = (n0 >> 7) * 256 + (n0 & 127) + (MAP == 2 ? 128 : 0);
        if (MAP == 3) drow0 = (n0 < 1024) ? n0 : (n0 < 1536) ? VDROW + (n0 - 1024) : n0 - 512;
        transpose_item<FOLD>(W, K, N, WT, 64 * kb, n0, drow0, scr, lane, g, b, PC, PB); }
}
__device__ __forceinline__ void convert_bf16(const float* __restrict__ src, bf16* __restrict__ dst, size_t n, size_t gt, size_t NGT) {
    const size_t nch = n / 8;
    for (size_t i0 = gt; i0 < nch; i0 += 4 * NGT) {
        f32x4 a[4], b[4];
#pragma unroll
        for (int u = 0; u < 4; ++u) { const size_t i = i0 + u * NGT; if (i < nch) { a[u] = *(const f32x4*)(src + 8 * i); b[u] = *(const f32x4*)(src + 8 * i + 4); } }
#pragma unroll
        for (int u = 0; u < 4; ++u) { const size_t i = i0 + u * NGT; if (i < nch) { v4u o; o.x = pk2(a[u].x, a[u].y); o.y = pk2(a[u].z, a[u].w); o.z = pk2(b[u].x, b[u].y); o.w = pk2(b[u].z, b[u].w); *(v4u*)(dst + 8 * i) = o; } }
    }
}
template <bool FINAL> __device__ __forceinline__ void ln_pass(float* V, const float* g, const float* b, bf16* HB, float* stats, int gw, int NGW, int lane) {
    f32x4 gv[4], bv[4];
#pragma unroll
    for (int j = 0; j < 4; ++j) { gv[j] = *((const f32x4*)g + lane + 64 * j); bv[j] = *((const f32x4*)b + lane + 64 * j); }
    for (int m = gw; m < T; m += NGW) {
        f32x4* xr = (f32x4*)(V + (size_t)m * D) + lane;
        f32x4 v[4]; float s = 0.f;
#pragma unroll
        for (int j = 0; j < 4; ++j) { v[j] = xr[64 * j]; s += (v[j].x + v[j].y) + (v[j].z + v[j].w); }
        const float mean = wave_sum(s) * (1.f / D); float s2 = 0.f;
#pragma unroll
        for (int j = 0; j < 4; ++j) { v[j] = v[j] - mean; s2 += (v[j].x * v[j].x + v[j].y * v[j].y) + (v[j].z * v[j].z + v[j].w * v[j].w); }
        const float rstd = 1.f / sqrtf(wave_sum(s2) * (1.f / D) + LN_EPS);
        if (FINAL) {
#pragma unroll
            for (int j = 0; j < 4; ++j) xr[64 * j] = v[j] * rstd * gv[j] + bv[j];
        } else {
            v2u* o8 = (v2u*)(HB + (size_t)m * D) + lane;
#pragma unroll
            for (int j = 0; j < 4; ++j) { const f32x4 y = v[j] * rstd * gv[j] + bv[j]; v2u o; o.x = pk2(y.x, y.y); o.y = pk2(y.z, y.w); o8[64 * j] = o; }
            if (lane == 0) { stats[2 * m] = mean; stats[2 * m + 1] = rstd; }
        }
    }
}

namespace da {
typedef short bf16x8 __attribute__((ext_vector_type(8)));
typedef float f32x16 __attribute__((ext_vector_type(16)));
constexpr int KROW = 272, VROW = 144, KBYTES = 64 * KROW, VBYTES = 128 * VROW, STAGE = KBYTES + VBYTES;
constexpr int XCH = 16384, STG_OFF = 4 * XCH, STG_BYTES = 32 * 272, NG_OFF = 3 * STAGE;
__device__ __forceinline__ int crow(int r, int hi) { return (r & 3) + 8 * (r >> 2) + 4 * hi; }
__device__ __forceinline__ unsigned pkbf(float lo, float hi) { typedef float f2 __attribute__((ext_vector_type(2))); typedef __bf16 b2 __attribute__((ext_vector_type(2))); f2 v = {lo, hi}; b2 b = __builtin_convertvector(v, b2); return __builtin_bit_cast(unsigned, b); }

__device__ __forceinline__ void da_unit(int b, int h, int qb, const bf16* __restrict__ QKV, const bf16* __restrict__ VT, bf16* __restrict__ MIX, unsigned char* lds, float lam, int tid, int lane, int wave) {
    const int c = wave >> 2, qg = wave & 3, q32 = lane & 31, hi = lane >> 5;
    const int NT = 2 * qb + 2, myT = 2 * qb + (qg >> 1);
    const size_t tokbase = (size_t)b * SEQ;
    const bf16* kg0 = QKV + (tokbase + (tid >> 4)) * NIN + KD + h * 128 + (tid & 15) * 8;
    const bf16* vg0 = VT + (size_t)(h * 128 + (tid >> 3)) * T + tokbase + (tid & 7) * 8;
    const int kl0 = (tid >> 4) * KROW + (tid & 15) * 16, vl0 = KBYTES + (tid >> 3) * VROW + ((tid & 7) >> 1) * 32 + (tid & 1) * 8;
    v4u rk[2], rv[2];
#define DA_LOAD(t) do { _Pragma("unroll") for (int i = 0; i < 2; ++i) { rk[i] = *(const v4u*)(kg0 + (size_t)((t) * 64 + i * 32) * NIN); rv[i] = *(const v4u*)(vg0 + (size_t)i * 64 * T + (t) * 64); } } while (0)
#define DA_STORE(sp) do { _Pragma("unroll") for (int i = 0; i < 2; ++i) { *(v4u*)((sp) + kl0 + i * 32 * KROW) = rk[i]; *(v2u*)((sp) + vl0 + i * 64 * VROW) = (v2u){rv[i].x, rv[i].y}; *(v2u*)((sp) + vl0 + i * 64 * VROW + 16) = (v2u){rv[i].z, rv[i].w}; } } while (0)
    DA_LOAD(0);
    const bf16* qp = QKV + (tokbase + 128 * qb + 32 * qg + q32) * NIN + QD + h * 128 + c * 64 + 8 * hi;
    bf16x8 qf[4];
#pragma unroll
    for (int d0 = 0; d0 < 4; ++d0) qf[d0] = *(const bf16x8*)(qp + 16 * d0);
    DA_STORE(lds);
    __syncthreads();
    f32x16 o[4];
#pragma unroll
    for (int j = 0; j < 4; ++j)
#pragma unroll
        for (int r = 0; r < 16; ++r) o[j][r] = 0.f;
    constexpr float THR = 8.f;
    float mref = 0.f, l = 0.f; f32x16 negm;
#pragma unroll
    for (int r = 0; r < 16; ++r) negm[r] = 0.f;
    bf16x8 pb[4];
#define DA_QKSM(soff) do { const unsigned char* kp = lds + (soff) + q32 * KROW + c * 128 + hi * 16; f32x16 p0, p1; \
        _Pragma("unroll") for (int d0 = 0; d0 < 4; ++d0) { const bf16x8 k0 = *(const bf16x8*)(kp + d0 * 32), k1 = *(const bf16x8*)(kp + 32 * KROW + d0 * 32); \
            if (d0 == 0) { p0 = __builtin_amdgcn_mfma_f32_32x32x16_bf16(k0, qf[0], negm, 0, 0, 0); p1 = __builtin_amdgcn_mfma_f32_32x32x16_bf16(k1, qf[0], negm, 0, 0, 0); } \
            else { p0 = __builtin_amdgcn_mfma_f32_32x32x16_bf16(k0, qf[d0], p0, 0, 0, 0); p1 = __builtin_amdgcn_mfma_f32_32x32x16_bf16(k1, qf[d0], p1, 0, 0, 0); } } \
        float mt = fmaxf(p0[0], p1[0]); \
        _Pragma("unroll") for (int r = 1; r < 16; ++r) mt = fmaxf(mt, fmaxf(p0[r], p1[r])); \
        mt = half_max(mt); \
        if (t == 0 || __any(mt > THR)) { const float dl = (t == 0) ? mt : fmaxf(mt, 0.f); mref += dl; \
            _Pragma("unroll") for (int r = 0; r < 16; ++r) { p0[r] -= dl; p1[r] -= dl; negm[r] = -mref; } \
            const float f = __builtin_amdgcn_exp2f(-dl); l *= f; \
            _Pragma("unroll") for (int j = 0; j < 4; ++j) _Pragma("unroll") for (int r = 0; r < 16; ++r) o[j][r] *= f; } \
        float ps = 0.f; \
        _Pragma("unroll") for (int r = 0; r < 16; ++r) { p0[r] = __builtin_amdgcn_exp2f(p0[r]); p1[r] = __builtin_amdgcn_exp2f(p1[r]); ps += p0[r] + p1[r]; } \
        l += ps; \
        _Pragma("unroll") for (int kk = 0; kk < 4; ++kk) { v4u w; \
            if (kk < 2) { w.x = pkbf(p0[8 * kk + 0], p0[8 * kk + 1]); w.y = pkbf(p0[8 * kk + 2], p0[8 * kk + 3]); w.z = pkbf(p0[8 * kk + 4], p0[8 * kk + 5]); w.w = pkbf(p0[8 * kk + 6], p0[8 * kk + 7]); } \
            else { const int k2 = kk - 2; w.x = pkbf(p1[8 * k2 + 0], p1[8 * k2 + 1]); w.y = pkbf(p1[8 * k2 + 2], p1[8 * k2 + 3]); w.z = pkbf(p1[8 * k2 + 4], p1[8 * k2 + 5]); w.w = pkbf(p1[8 * k2 + 6], p1[8 * k2 + 7]); } \
            pb[kk] = __builtin_bit_cast(bf16x8, w); } } while (0)
#define DA_PV(soff) do { const unsigned char* vp = lds + (soff) + KBYTES + q32 * VROW + hi * 16; \
        _Pragma("unroll") for (int j = 0; j < 4; ++j) _Pragma("unroll") for (int kk = 0; kk < 4; ++kk) { const bf16x8 vf = *(const bf16x8*)(vp + j * 32 * VROW + kk * 32); o[j] = __builtin_amdgcn_mfma_f32_32x32x16_bf16(vf, pb[kk], o[j], 0, 0, 0); } } while (0)
    int s_prev = 2 * STAGE, s_cur = 0, s_nxt = STAGE;
    for (int t = 0; t < NT; ++t) {
        const bool more = (t + 1 < NT);
        if (more) DA_LOAD(t + 1);
        if (c == 1 && t >= 1 && t - 1 <= myT) DA_PV(s_prev);
        if (t <= myT) DA_QKSM(s_cur);
        if (c == 0 && t <= myT) DA_PV(s_cur);
        if (more) DA_STORE(lds + s_nxt);
        __syncthreads();
        { const int tmp = s_prev; s_prev = s_cur; s_cur = s_nxt; s_nxt = tmp; }
    }
    if (c == 1 && myT == NT - 1) DA_PV(s_prev);
    __syncthreads();
#undef DA_QKSM
#undef DA_PV
#undef DA_LOAD
#undef DA_STORE
    l = half_sum(l);
    float* xch = (float*)(lds + qg * XCH);
    if (c == 1) { const float f = lam / l;
#pragma unroll
        for (int j = 0; j < 4; ++j)
#pragma unroll
            for (int r = 0; r < 16; ++r) xch[(32 * j + crow(r, hi)) * 32 + q32] = o[j][r] * f; }
    __syncthreads();
    if (c == 0) { const float il = 1.f / l; float ss = 0.f;
#pragma unroll
        for (int j = 0; j < 4; ++j)
#pragma unroll
            for (int r = 0; r < 16; ++r) { const float v = o[j][r] * il - xch[(32 * j + crow(r, hi)) * 32 + q32]; o[j][r] = v; ss += v * v; }
        ss = half_sum(ss);
        const float rr = 1.f / sqrtf(ss * (1.f / 128.f) + LN_EPS);
        const float* ngs = (const float*)(lds + NG_OFF);
        unsigned char* stg = lds + STG_OFF + qg * STG_BYTES;
#pragma unroll
        for (int j = 0; j < 4; ++j)
#pragma unroll
            for (int r4 = 0; r4 < 4; ++r4) { const int dv0 = 32 * j + 8 * r4 + 4 * hi; const f32x4 gv = *(const f32x4*)(ngs + dv0);
                v2u w; w.x = pkbf(o[j][4 * r4 + 0] * rr * gv.x, o[j][4 * r4 + 1] * rr * gv.y); w.y = pkbf(o[j][4 * r4 + 2] * rr * gv.z, o[j][4 * r4 + 3] * rr * gv.w);
                *(v2u*)(stg + q32 * 272 + dv0 * 2) = w; }
        asm volatile("s_waitcnt lgkmcnt(0)" ::: "memory");
        bf16* orow = MIX + (tokbase + 128 * qb + 32 * qg) * D + h * 128;
#pragma unroll
        for (int i = 0; i < 8; ++i) { const int idx = lane + 64 * i, row = idx >> 4, pc = idx & 15; const v4u v = *(const v4u*)(stg + row * 272 + pc * 16); *(v4u*)(orow + (size_t)row * D + pc * 8) = v; }
    }
    __syncthreads();
}
__device__ __forceinline__ void da_phase(const bf16* QKV, const bf16* VT, bf16* MIX, const float* ng, float lam, unsigned char* lds, int bx, int G, int tid, int lane, int wave) {
    if (tid < 128) ((float*)(lds + NG_OFF))[tid] = ng[tid] * (1.f - LAMBDA_INIT);
    __syncthreads();
    if (G == 256) { const int v = (bx & 7) * 32 + (bx >> 3), bh = v >> 3, s = v & 7;
        for (int i = 0; i < 4; ++i) { const int qb = (i == 0) ? 31 - s : (i == 1) ? s : (i == 2) ? 23 - s : 8 + s; da_unit(bh >> 2, bh & 3, qb, QKV, VT, MIX, lds, lam, tid, lane, wave); }
    } else { for (int it = bx; it < 1024; it += G) da_unit((it >> 5) >> 2, (it >> 5) & 3, it & 31, QKV, VT, MIX, lds, lam, tid, lane, wave); }
}
}
namespace xa {
typedef short bf16x8 __attribute__((ext_vector_type(8)));
typedef float f32x16 __attribute__((ext_vector_type(16)));
constexpr int ROW = 144, STAGE = 256 * ROW, OSTG = 32 * 272;
__device__ __forceinline__ void xa_unit(int b, int hd, int qb, const bf16* __restrict__ QC, const bf16* __restrict__ KC, const bf16* __restrict__ VCT, bf16* __restrict__ OC, unsigned char* lds, int tid, int lane, int wave) {
    const int q32 = lane & 31, hi = lane >> 5;
    const size_t tok0 = (size_t)b * SEQ + 256 * qb + 32 * wave;
    const int r0 = tid >> 3, pc = tid & 7;
    const char* kbase = (const char*)(KC + (size_t)(b * MEM) * D + hd * 256);
    const char* vbase = (const char*)(VCT + (size_t)(hd * 256) * TM + b * MEM);
    const char* qbase = (const char*)(QC + tok0 * D + hd * 256);
    const unsigned kvo_ = (unsigned)(r0 * D + pc * 8) * 2u, vvo_ = (unsigned)(r0 * TM + pc * 8) * 2u, qvo_ = (unsigned)(q32 * D + 8 * hi) * 2u;
    unsigned kvo = kvo_, vvo = vvo_, qvo = qvo_;
    const int kl0 = r0 * ROW + pc * 16, vl0 = r0 * ROW + (pc >> 1) * 32 + (pc & 1) * 8;
#define XA_KLD(i, ch) (*(const v4u*)(kbase + (size_t)((i) * 64 * D + (ch) * 64) * 2 + kvo))
#define XA_VLD(i, hf, ch) (*(const v4u*)(vbase + (size_t)(((hf) * 128 + (i) * 64) * TM + (ch) * 64) * 2 + vvo))
#define XA_QLD(ch, d0) (*(const bf16x8*)(qbase + (size_t)((ch) * 64 + 16 * (d0)) * 2 + qvo))
    v4u rg[4];
#pragma unroll
    for (int i = 0; i < 4; ++i) rg[i] = XA_KLD(i, 0);
    bf16x8 qf[4];
#pragma unroll
    for (int d0 = 0; d0 < 4; ++d0) qf[d0] = XA_QLD(0, d0);
#pragma unroll
    for (int i = 0; i < 4; ++i) *(v4u*)(lds + kl0 + i * 64 * ROW) = rg[i];
    __syncthreads();
    f32x16 p[8], o[4]; bf16x8 pb[16]; float l = 0.f;
#pragma unroll
    for (int kb = 0; kb < 8; ++kb)
#pragma unroll
        for (int r = 0; r < 16; ++r) p[kb][r] = 0.f;
#pragma unroll
    for (int s = 0; s < 12; ++s) {
        kvo = kvo_; vvo = vvo_; qvo = qvo_; asm volatile("" : "+v"(kvo), "+v"(vvo), "+v"(qvo));
        if (s + 1 < 4) {
#pragma unroll
            for (int i = 0; i < 4; ++i) rg[i] = XA_KLD(i, s + 1);
        } else if (s + 1 < 12) { const int hn = (s + 1 - 4) >> 2, kn = (s + 1 - 4) & 3;
#pragma unroll
            for (int i = 0; i < 2; ++i) rg[i] = XA_VLD(i, hn, kn);
        }
        const unsigned char* cur = lds + (s & 1) * STAGE + q32 * ROW + hi * 16;
        if (s < 4) {
#pragma unroll
            for (int kb = 0; kb < 8; ++kb)
#pragma unroll
                for (int d0 = 0; d0 < 4; ++d0) { const bf16x8 kf = *(const bf16x8*)(cur + kb * 32 * ROW + d0 * 32); p[kb] = __builtin_amdgcn_mfma_f32_32x32x16_bf16(kf, qf[d0], p[kb], 0, 0, 0); if (d0 == 3 && (kb & 1)) __builtin_amdgcn_sched_barrier(0); }
            if (s + 1 < 4) {
#pragma unroll
                for (int d0 = 0; d0 < 4; ++d0) qf[d0] = XA_QLD(s + 1, d0);
            }
            if (s == 3) {
                float mt = p[0][0];
#pragma unroll
                for (int kb = 0; kb < 8; ++kb)
#pragma unroll
                    for (int r = 0; r < 16; ++r) mt = fmaxf(mt, p[kb][r]);
                mt = half_max(mt);
#pragma unroll
                for (int kb = 0; kb < 8; ++kb) {
#pragma unroll
                    for (int r = 0; r < 16; ++r) { p[kb][r] = __builtin_amdgcn_exp2f(p[kb][r] - mt); l += p[kb][r]; }
#pragma unroll
                    for (int hh = 0; hh < 2; ++hh) { v4u w; w.x = da::pkbf(p[kb][8 * hh + 0], p[kb][8 * hh + 1]); w.y = da::pkbf(p[kb][8 * hh + 2], p[kb][8 * hh + 3]); w.z = da::pkbf(p[kb][8 * hh + 4], p[kb][8 * hh + 5]); w.w = da::pkbf(p[kb][8 * hh + 6], p[kb][8 * hh + 7]);
                        pb[2 * kb + hh] = __builtin_bit_cast(bf16x8, w); } }
                l = half_sum(l);
            }
        } else {
            const int half = (s - 4) >> 2, kc = (s - 4) & 3;
            if (kc == 0) {
#pragma unroll
                for (int j = 0; j < 4; ++j)
#pragma unroll
                    for (int r = 0; r < 16; ++r) o[j][r] = 0.f;
            }
#pragma unroll
            for (int j = 0; j < 4; ++j)
#pragma unroll
                for (int kk = 0; kk < 4; ++kk) { const bf16x8 vf = *(const bf16x8*)(cur + j * 32 * ROW + kk * 32); o[j] = __builtin_amdgcn_mfma_f32_32x32x16_bf16(vf, pb[4 * kc + kk], o[j], 0, 0, 0); if (kk == 3 && (j & 1)) __builtin_amdgcn_sched_barrier(0); }
            if (kc == 3) {
                const float il = 1.f / l;
                unsigned char* stg = lds + 2 * STAGE + wave * OSTG;
#pragma unroll
                for (int j = 0; j < 4; ++j)
#pragma unroll
                    for (int r4 = 0; r4 < 4; ++r4) { const int dv0 = 32 * j + 8 * r4 + 4 * hi;
                        v2u w; w.x = da::pkbf(o[j][4 * r4 + 0] * il, o[j][4 * r4 + 1] * il); w.y = da::pkbf(o[j][4 * r4 + 2] * il, o[j][4 * r4 + 3] * il);
                        *(v2u*)(stg + q32 * 272 + dv0 * 2) = w; }
                asm volatile("s_waitcnt lgkmcnt(0)" ::: "memory");
                bf16* orow = OC + tok0 * D + hd * 256 + half * 128;
#pragma unroll
                for (int i = 0; i < 8; ++i) { const int idx = lane + 64 * i, row = idx >> 4, pq = idx & 15; const v4u v = *(const v4u*)(stg + row * 272 + pq * 16); *(v4u*)(orow + (size_t)row * D + pq * 8) = v; }
                asm volatile("s_waitcnt lgkmcnt(0)" ::: "memory");
            }
        }
        if (s + 1 < 12) { unsigned char* sn = lds + ((s + 1) & 1) * STAGE;
            if (s + 1 < 4) {
#pragma unroll
                for (int i = 0; i < 4; ++i) *(v4u*)(sn + kl0 + i * 64 * ROW) = rg[i];
            } else {
#pragma unroll
                for (int i = 0; i < 2; ++i) { *(v2u*)(sn + vl0 + i * 64 * ROW) = (v2u){rg[i].x, rg[i].y}; *(v2u*)(sn + vl0 + i * 64 * ROW + 16) = (v2u){rg[i].z, rg[i].w}; }
            } }
        __syncthreads();
    }
}
__device__ __forceinline__ void xa_phase(const bf16* QC, const bf16* KC, const bf16* VCT, bf16* OC, unsigned char* lds, int bx, int G, int tid, int lane, int wave) {
    const int v = (G % 8 == 0) ? (bx & 7) * (G / 8) + (bx >> 3) : bx;
    for (int u = v * 2; u < 512; u += 2 * G) {
#pragma unroll 1
        for (int i = 0; i < 2; ++i) { const int uu = u + i, bh = uu >> 4; xa_unit(bh >> 2, bh & 3, uu & 15, QC, KC, VCT, OC, lds, tid, lane, wave); } }
}
}
namespace gla {
typedef short bf16x8 __attribute__((ext_vector_type(8)));
typedef float f32x16 __attribute__((ext_vector_type(16)));
constexpr int ROW = 144;
__device__ __forceinline__ float fast_exp(float x) { return __builtin_amdgcn_exp2f(x * LOG2E); }
__device__ __forceinline__ float log_sigmoid(float z) { return fminf(z, 0.f) - 0.6931471805599453f * __builtin_amdgcn_logf(1.f + fast_exp(-fabsf(z))); }
__device__ __forceinline__ void step1(const bf16* __restrict__ QKV, const float* __restrict__ W2, const float* __restrict__ bg, bf16* __restrict__ DS, float* __restrict__ DEC, unsigned char* lds, int bx, int G, int tid, int lane, int wave) {
    unsigned char* vT = lds;
    unsigned char* keT = lds + 128 * ROW;
    const int q32 = lane & 31, hi = lane >> 5;
    v4u nv0, nv1, ng0, ng1, nkk;
#define GLA1_LOAD(it_) do { const int h_ = (it_) & 3; const bf16* row_ = QKV + (size_t)(((it_) >> 2) * 64 + lane) * NIN; \
        nv0 = *(const v4u*)(row_ + VG + h_ * 128 + wave * 8); nv1 = *(const v4u*)(row_ + VG + h_ * 128 + (wave + 8) * 8); ng0 = *(const v4u*)(row_ + GL); ng1 = *(const v4u*)(row_ + GL + 8); nkk = *(const v4u*)(row_ + KG + h_ * 64 + wave * 8); } while (0)
    if (bx < BATCH * 64 * 4) GLA1_LOAD(bx);
    for (int item = bx; item < BATCH * 64 * 4; item += G) {
        const int h = item & 3;
        const v4u v0 = nv0, v1 = nv1, g0 = ng0, g1 = ng1, kk = nkk;
        if (item + G < BATCH * 64 * 4) GLA1_LOAD(item + G);
#pragma unroll
        for (int i = 0; i < 2; ++i) { const v4u vv = i ? v1 : v0; unsigned char* d = vT + ((wave + 8 * i) * 8) * ROW + lane * 2;
            *(bf16*)(d + 0 * ROW) = (bf16)(vv.x & 0xffffu); *(bf16*)(d + 1 * ROW) = (bf16)(vv.x >> 16); *(bf16*)(d + 2 * ROW) = (bf16)(vv.y & 0xffffu); *(bf16*)(d + 3 * ROW) = (bf16)(vv.y >> 16);
            *(bf16*)(d + 4 * ROW) = (bf16)(vv.z & 0xffffu); *(bf16*)(d + 5 * ROW) = (bf16)(vv.z >> 16); *(bf16*)(d + 6 * ROW) = (bf16)(vv.w & 0xffffu); *(bf16*)(d + 7 * ROW) = (bf16)(vv.w >> 16); }
        const float gl[16] = {bflo(g0.x), bfhi(g0.x), bflo(g0.y), bfhi(g0.y), bflo(g0.z), bfhi(g0.z), bflo(g0.w), bfhi(g0.w), bflo(g1.x), bfhi(g1.x), bflo(g1.y), bfhi(g1.y), bflo(g1.z), bfhi(g1.z), bflo(g1.w), bfhi(g1.w)};
        const float kf[8] = {bflo(kk.x), bfhi(kk.x), bflo(kk.y), bfhi(kk.y), bflo(kk.z), bfhi(kk.z), bflo(kk.w), bfhi(kk.w)};
        const float* w2 = W2 + h * 64 + wave * 8;
        float cum[8];
#pragma unroll
        for (int j = 0; j < 8; ++j) { float z = bg[h * 64 + wave * 8 + j];
#pragma unroll
            for (int r = 0; r < 16; ++r) z += gl[r] * w2[r * 256 + j];
            cum[j] = log_sigmoid(z) * (1.f / 16.f); }
#pragma unroll
        for (int off = 1; off < 64; off <<= 1) { const int src = ((lane - off) & 63) << 2;
#pragma unroll
            for (int j = 0; j < 8; ++j) { const float t = __int_as_float(__builtin_amdgcn_ds_bpermute(src, __float_as_int(cum[j]))); if (lane >= off) cum[j] += t; } }
#pragma unroll
        for (int j = 0; j < 8; ++j) { const float tot = __int_as_float(__builtin_amdgcn_readlane(__float_as_int(cum[j]), 63));
            const float ke = kf[j] * fast_exp(tot - cum[j]);
            *(bf16*)(keT + (wave * 8 + j) * ROW + lane * 2) = (bf16)f2bf(ke);
            if (lane == 0) DEC[(size_t)item * 64 + wave * 8 + j] = fast_exp(tot); }
        __syncthreads();
        { const int dvb = wave & 3, dkb = wave >> 2;
            const unsigned char* ap = keT + (32 * dkb + q32) * ROW + hi * 16; const unsigned char* bp = vT + (32 * dvb + q32) * ROW + hi * 16;
            f32x16 acc;
#pragma unroll
            for (int r = 0; r < 16; ++r) acc[r] = 0.f;
#pragma unroll
            for (int ks = 0; ks < 4; ++ks) acc = __builtin_amdgcn_mfma_f32_32x32x16_bf16(*(const bf16x8*)(ap + ks * 32), *(const bf16x8*)(bp + ks * 32), acc, 0, 0, 0);
            bf16* ds = DS + (size_t)item * 8192 + (32 * dvb + q32) * 64 + 32 * dkb + 4 * hi;
#pragma unroll
            for (int r4 = 0; r4 < 4; ++r4) { v2u w; w.x = da::pkbf(acc[4 * r4 + 0], acc[4 * r4 + 1]); w.y = da::pkbf(acc[4 * r4 + 2], acc[4 * r4 + 3]); *(v2u*)(ds + 8 * r4) = w; } }
        __syncthreads();
    }
}
__device__ __forceinline__ void scan(bf16* __restrict__ DS, const float* __restrict__ DEC, int gt, int NGT) {
    for (int p = gt; p < BATCH * 4 * 4096; p += NGT) {
        const int e = 2 * p, bh = e >> 13, rem = e & 8191, b = bh >> 2, h = bh & 3, dk = rem & 63;
        float s0 = 0.f, s1 = 0.f;
#pragma unroll 8
        for (int c = 0; c < 64; ++c) { const size_t item = (size_t)((b * 64 + c) * 4 + h);
            const unsigned d = *(const unsigned*)(DS + item * 8192 + rem); const float dc0 = DEC[item * 64 + dk], dc1 = DEC[item * 64 + dk + 1];
            s0 = dc0 * s0 + bflo(d); s1 = dc1 * s1 + bfhi(d);
            *(unsigned*)(DS + item * 8192 + rem) = da::pkbf(s0, s1); }
    }
}
__device__ __forceinline__ void step3(const bf16* __restrict__ QKV, const bf16* __restrict__ DS, const float* __restrict__ ng, bf16* __restrict__ MIX, unsigned char* lds, int bx, int G, int tid, int lane, int wave) {
    const int q32 = lane & 31, hi = lane >> 5;
    for (int it = bx; it < BATCH * 64; it += G) {
        const int tok0 = it * 64;
        const bf16* ds = DS + (size_t)it * 4 * 8192;
        const int h = wave >> 1, sb = wave & 1; const size_t tok = (size_t)tok0 + 32 * sb + q32;
        const bf16* qrow = QKV + tok * NIN + QG + h * 64 + 8 * hi;
        bf16x8 qf[4];
#pragma unroll
        for (int ks = 0; ks < 4; ++ks) qf[ks] = *(const bf16x8*)(qrow + 16 * ks);
#pragma unroll 4
        for (int i = 0; i < 8; ++i) { const int idx = tid + 512 * i, itl = idx >> 10, f = idx & 1023; const v4u v = *(const v4u*)(ds + 8 * idx);
            *(v4u*)(lds + itl * (128 * ROW) + (f >> 3) * ROW + (f & 7) * 16) = v; }
        __syncthreads();
        const unsigned char* ap = lds + h * (128 * ROW) + q32 * ROW + hi * 16;
        f32x16 o[4];
#pragma unroll
        for (int j = 0; j < 4; ++j) {
#pragma unroll
            for (int r = 0; r < 16; ++r) o[j][r] = 0.f;
#pragma unroll
            for (int ks = 0; ks < 4; ++ks) o[j] = __builtin_amdgcn_mfma_f32_32x32x16_bf16(*(const bf16x8*)(ap + j * 32 * ROW + ks * 32), qf[ks], o[j], 0, 0, 0); }
        float ss = 0.f;
#pragma unroll
        for (int j = 0; j < 4; ++j)
#pragma unroll
            for (int r = 0; r < 16; ++r) { o[j][r] *= 0.125f; ss += o[j][r] * o[j][r]; }
        ss = half_sum(ss);
        const float rr = 1.f / sqrtf(ss * (1.f / 128.f) + LN_EPS);
        const bf16* rrow = QKV + tok * NIN + RG + h * 128; bf16* orow = MIX + tok * D + 512 + h * 128;
#pragma unroll
        for (int j = 0; j < 4; ++j)
#pragma unroll
            for (int r4 = 0; r4 < 4; ++r4) { const int dv0 = 32 * j + 8 * r4 + 4 * hi; const f32x4 gv = *(const f32x4*)(ng + dv0); const v2u rg = *(const v2u*)(rrow + dv0);
                v2u w; w.x = da::pkbf(o[j][4 * r4 + 0] * rr * gv.x * pg8::silu_f(bflo(rg.x)), o[j][4 * r4 + 1] * rr * gv.y * pg8::silu_f(bfhi(rg.x)));
                w.y = da::pkbf(o[j][4 * r4 + 2] * rr * gv.z * pg8::silu_f(bflo(rg.y)), o[j][4 * r4 + 3] * rr * gv.w * pg8::silu_f(bfhi(rg.y)));
                *(v2u*)(orow + dv0) = w; if (r4 == 3) asm volatile("" ::: "memory"); }
        __syncthreads();
    }
}
}
#define XB_TMO      128
#define XB_XCNT(j)  (256  + 64 * (j))
#define XB_XSUB(j)  (1280 + 64 * (j))
#define XB_XGEN(j)  (2304 + 64 * (j))
#define XB_TOP      3328
#define XB_TOPGEN   3392
#define XCD_BAR_WORDS 3456
#define XB_SPIN_CAP (1u << 18)

__device__ __forceinline__ unsigned xb_ld(unsigned* p)              { return __hip_atomic_load(p, __ATOMIC_RELAXED, __HIP_MEMORY_SCOPE_AGENT); }
__device__ __forceinline__ unsigned xb_add(unsigned* p, unsigned v) { return __hip_atomic_fetch_add(p, v, __ATOMIC_RELAXED, __HIP_MEMORY_SCOPE_AGENT); }
__device__ __forceinline__ unsigned xb_xcc_id() { return (unsigned)__builtin_amdgcn_s_getreg((3 << 11) | 20) & 0xFu; }
#define XB_SPIN(cond, bar) do { unsigned _sp = 0; while (cond) { __builtin_amdgcn_s_sleep(1); \
    if ((++_sp & 255u) == 0u) { if (xb_ld(&(bar)[XB_TMO])) break; if (_sp > XB_SPIN_CAP) { atomicAdd(&(bar)[XB_TMO], 1u); break; } } } } while (0)

struct XcdBarrier {
    unsigned* bar; unsigned x;
    volatile LAS unsigned* st;
};

__device__ __forceinline__ XcdBarrier xcd_barrier_post(unsigned* bar, volatile LAS unsigned* st) {
    XcdBarrier b; b.bar = bar; b.x = xb_xcc_id(); b.st = st;
    if (threadIdx.x == 0) (void)xb_add(&bar[XB_XCNT(b.x)], 1u);
    return b;
}
__device__ __forceinline__ void xcd_barrier_complete(unsigned* bar, unsigned x, unsigned& nloc, unsigned& nx) {
    const unsigned G = gridDim.x * gridDim.y * gridDim.z;
    unsigned sum, cnt, mine, sp = 0u;
    for (;;) {
        sum = 0u; cnt = 0u; mine = 0u;
#pragma unroll
        for (unsigned j = 0; j < 16; ++j) { const unsigned c = xb_ld(&bar[XB_XCNT(j)]); sum += c; cnt += (c > 0u) ? 1u : 0u; mine = (j == x) ? c : mine; }
        if (sum == G) break;
        __builtin_amdgcn_s_sleep(1);
        if ((++sp & 255u) == 0u) { if (xb_ld(&bar[XB_TMO])) break; if (sp > XB_SPIN_CAP) { atomicAdd(&bar[XB_TMO], 1u); break; } }
    }
    nloc = mine > 0u ? mine : 1u; nx = cnt > 0u ? cnt : 1u;
}

__device__ __forceinline__ void xcd_barrier(const XcdBarrier& b) {
    asm volatile("s_waitcnt vmcnt(0)" ::: "memory");
    __syncthreads();
    if (threadIdx.x == 0) {
        unsigned* bar = b.bar;
        __builtin_amdgcn_s_waitcnt(0);
        unsigned nloc = b.st[0], nx = b.st[1];
        if (nloc == 0u) { xcd_barrier_complete(bar, b.x, nloc, nx); b.st[0] = nloc; b.st[1] = nx; }
        const unsigned old = xb_add(&bar[XB_XSUB(b.x)], 1u);
        const unsigned gen = old / nloc;
        if (old + 1u == (gen + 1u) * nloc) {
            __builtin_amdgcn_fence(__ATOMIC_RELEASE, "agent");
            asm volatile("s_waitcnt vmcnt(0)" ::: "memory");
            const unsigned og = xb_add(&bar[XB_TOP], 1u);
            const unsigned tg = og / nx;
            if (og + 1u == (tg + 1u) * nx) xb_add(&bar[XB_TOPGEN], 1u);
            else XB_SPIN(xb_ld(&bar[XB_TOPGEN]) == tg, bar);
            __builtin_amdgcn_fence(__ATOMIC_ACQUIRE, "agent");
            xb_add(&bar[XB_XGEN(b.x)], 1u);
            asm volatile("s_waitcnt vmcnt(0)" ::: "memory");
        } else {
            XB_SPIN(xb_ld(&bar[XB_XGEN(b.x)]) == gen, bar);
            __builtin_amdgcn_fence(__ATOMIC_ACQUIRE, "agent");
            asm volatile("s_waitcnt vmcnt(0)" ::: "memory");
        }
    }
    __syncthreads();
}

struct Args { const float* in[29]; float* out; unsigned char* ws; };
#define GEMM_PHASE(EPI, Aptr, Bptr, M_, N_, K_, Eobj) GEMM_PHASE_R(EPI, Aptr, Bptr, M_, N_, K_, Eobj, 0)
#define GEMM_PHASE_S(EPI, Aptr, Bptr, M_, N_, K_, Eobj, PSTp, BYPN, CSp, BWp) do { pg8::Gemm g_{(const pg8::bf16_t*)(Aptr), (const pg8::bf16_t*)(Bptr), (M_), (N_), (K_)}; pg8::StatsOrder S_; S_.init((M_), (N_), G, bx); S_.PST = (PSTp); S_.sbuf = ldsp + 139264; S_.by_pn = (BYPN); S_.cs = (CSp); S_.bw = (BWp); S_.cbuf = ldsp + 131072; S_.k = 0; \
    pg8::gemm_phase<EPI, pg8::StatsOrder, true, true>(ldsp, g_, S_, Eobj); } while (0)
#define GEMM_PHASE_R(EPI, Aptr, Bptr, M_, N_, K_, Eobj, ROT) do { pg8::Gemm g_{(const pg8::bf16_t*)(Aptr), (const pg8::bf16_t*)(Bptr), (M_), (N_), (K_)}; pg8::StaticOrder S_; S_.init((M_), (N_), G, (bx + (ROT)) % G); \
    pg8::gemm_phase<EPI, pg8::StaticOrder, true, true>(ldsp, g_, S_, Eobj); } while (0)

#ifndef REP_P0
#define REP_P0 1
#endif
#ifndef REP_GU
#define REP_GU 1
#endif
#ifndef REP_LN
#define REP_LN 1
#endif
#ifndef REP_WIN
#define REP_WIN 1
#endif
#ifndef REP_GLA1
#define REP_GLA1 1
#endif
#ifndef REP_DA
#define REP_DA 1
#endif
#ifndef REP_GLA3
#define REP_GLA3 1
#endif
#ifndef REP_WQ
#define REP_WQ 1
#endif
#ifndef REP_XA
#define REP_XA 1
#endif
#define REP(n) _Pragma("unroll 1") for (int rep_ = 0; rep_ < (n); ++rep_)
__global__ void __launch_bounds__(512, 2) mk_fwd(Args a) {
    extern __shared__ __attribute__((aligned(16))) unsigned char lds[];
    cg::grid_group grid = cg::this_grid();
    LAS unsigned char* ldsp = (LAS unsigned char*)lds;
    const int G = gridDim.x, bx = blockIdx.x, NGW = G * 8; const size_t NGT = (size_t)G * 512;
#define TIDS() int tid = threadIdx.x; asm volatile("" : "+v"(tid)); const int lane = tid & 63, wave = __builtin_amdgcn_readfirstlane(tid >> 6), gw = bx * 8 + wave; const size_t gt = (size_t)bx * 512 + tid; (void)lane; (void)gw; (void)gt;
    unsigned char* ws = a.ws;
    volatile LAS unsigned* bst = (volatile LAS unsigned*)(ldsp + LDS_BYTES - 64);
    if (threadIdx.x < 2) bst[threadIdx.x] = 0u;
    __syncthreads();
    const XcdBarrier bar = xcd_barrier_post((unsigned*)(ws + WS_CTL), bst);
    bf16 *Wgu1 = (bf16*)(ws + WS_GU1), *Wd1 = (bf16*)(ws + WS_D1), *Win = (bf16*)(ws + WS_WIN), *Wout = (bf16*)(ws + WS_WOUT), *Wq = (bf16*)(ws + WS_WQ), *Wkv = (bf16*)(ws + WS_WKV), *Wo = (bf16*)(ws + WS_WO),
         *Wgu2 = (bf16*)(ws + WS_GU2), *Wd2 = (bf16*)(ws + WS_D2), *MB = (bf16*)(ws + WS_MB), *KC = (bf16*)(ws + WS_KVC), *VCT = (bf16*)(ws + WS_KVC + 4 * MiB), *XB = (bf16*)(ws + WS_XB), *MIX = XB, *HB = (bf16*)(ws + WS_HB),
         *Hh = (bf16*)(ws + WS_R1), *QKV = Hh, *QC = Hh, *OC = (bf16*)(ws + WS_R1 + 64 * MiB), *VT = (bf16*)(ws + WS_VT);
    float *PSTA = (float*)(ws + WS_PSTA), *PSTB = (float*)(ws + WS_PSTB), *PARTC = (float*)(ws + WS_PARTC), *PARTB = (float*)(ws + WS_PARTB), *CS = (float*)(ws + WS_CS), *BW = (float*)(ws + WS_BW);
    PG8_LAS float* red = (PG8_LAS float*)(ldsp + 131072); const PG8_LAS float* sbl = (const PG8_LAS float*)(ldsp + 139264); const PG8_LAS float* cbl = (const PG8_LAS float*)(ldsp + 131072);
    float *stats = (float*)(ws + WS_STATS), *DEC = (float*)(ws + WS_DEC), *V = a.out; bf16* DS = (bf16*)(ws + WS_DS);

    REP(REP_P0) {   TIDS();
        float* scr = (float*)(lds + wave * 16640);
        transpose_matrix<1, false>(a.in[2], D, FH, Wgu1, scr, gw, NGW, lane);
        transpose_matrix<2, false>(a.in[3], D, FH, Wgu1, scr, gw, NGW, lane);
        transpose_matrix<0, false>(a.in[4], FH, D, Wd1, scr, gw, NGW, lane);
        transpose_matrix<3, true>(a.in[7], D, 3088, Win, scr, gw, NGW, lane, a.in[5], a.in[6], PARTC + WIN_OFF, PARTB + WIN_OFF);
        transpose_matrix<0, false>(a.in[16], D, D, Wout, scr, gw, NGW, lane);
        transpose_matrix<0, true>(a.in[19], D, D, Wq, scr, gw, NGW, lane, a.in[17], a.in[18], PARTC + WQ_OFF, PARTB + WQ_OFF);
        transpose_matrix<0, false>(a.in[20], D, 2 * D, Wkv, scr, gw, NGW, lane);
        transpose_matrix<0, false>(a.in[21], D, D, Wo, scr, gw, NGW, lane);
        transpose_matrix<1, true>(a.in[24], D, FH, Wgu2, scr, gw, NGW, lane, a.in[22], a.in[23], PARTC + GU2_OFF, PARTB + GU2_OFF);
        transpose_matrix<2, true>(a.in[25], D, FH, Wgu2, scr, gw, NGW, lane, a.in[22], a.in[23], PARTC + GU2_OFF, PARTB + GU2_OFF);
        transpose_matrix<0, false>(a.in[26], FH, D, Wd2, scr, gw, NGW, lane);
        for (size_t i = gt; i < (size_t)(NIN - 2624) * D / 8; i += NGT) *(v4u*)(Win + (size_t)2624 * D + 8 * i) = (v4u){0u, 0u, 0u, 0u};
        convert_bf16(a.in[0], XB, (size_t)T * D, gt, NGT);
        convert_bf16(a.in[1], MB, (size_t)TM * D, gt, NGT);
    }
    if (a.ws == nullptr) grid.sync();
    xcd_barrier(bar);
    {   TIDS();
        for (int r = (int)gt; r < PTOT; r += (int)NGT) { float c = 0.f, w = 0.f;
            if (!(r >= 2624 && r < 2816)) {
#pragma unroll
                for (int kb = 0; kb < 16; ++kb) { c += PARTC[(size_t)kb * PTOT + r]; w += PARTB[(size_t)kb * PTOT + r]; } }
            CS[r] = c; BW[r] = w; }
    }
    REP(REP_GU) { pg8::EpiSwiglu E{Hh, FH}; GEMM_PHASE(pg8::EpiSwiglu, XB, Wgu1, T, 2 * FH, D, E); }
    xcd_barrier(bar);
    { typedef pg8::EpiResidS<0, true> EP; EP E{V, XB, sbl, nullptr, nullptr, HB, PSTA, red, D, ALPHA, 0.5f, 0}; GEMM_PHASE(EP, Hh, Wd1, T, D, FH, E); }
    xcd_barrier(bar);
    REP(REP_WIN) { pg8::EpiStoreLn E{QKV, NIN, 2, C2_DA, sbl, cbl, 0}; GEMM_PHASE_S(pg8::EpiStoreLn, HB, Win, T, NIN, D, E, PSTA, 0, CS + WIN_OFF, BW + WIN_OFF); }
    { pg8::EpiStoreLnT E{VT, T, sbl, cbl, 0}; GEMM_PHASE_S(pg8::EpiStoreLnT, Win + (size_t)VDROW * D, HB, 512, T, D, E, PSTA, 1, CS + WIN_OFF + VDROW, BW + WIN_OFF + VDROW); }
    { pg8::EpiStore E{KC, D, 0, 1.f}; GEMM_PHASE_R(pg8::EpiStore, MB, Wkv, TM, D, D, E, 128); }
    { pg8::EpiStore E{VCT, TM, 0, 1.f}; GEMM_PHASE_R(pg8::EpiStore, Wkv + (size_t)D * D, MB, D, TM, D, E, 64); }
    xcd_barrier(bar);
    REP(REP_GLA1) { TIDS(); gla::step1(QKV, a.in[13], a.in[14], DS, DEC, lds, bx, G, tid, lane, wave); }
    xcd_barrier(bar);
    {   TIDS();
        gla::scan(DS, DEC, (int)gt, (int)NGT);
        const float sa = wave_sum(a.in[8][lane] * a.in[9][lane]), sb = wave_sum(a.in[10][lane] * a.in[11][lane]);
        const float lam = expf(sa) - expf(sb) + LAMBDA_INIT;
        REP(REP_DA) da::da_phase(QKV, VT, MIX, a.in[12], lam, lds, bx, G, tid, lane, wave);
    }
    xcd_barrier(bar);
    REP(REP_GLA3) { TIDS(); gla::step3(QKV, DS, a.in[15], MIX, lds, bx, G, tid, lane, wave); }
    xcd_barrier(bar);
    { typedef pg8::EpiResidS<1, true> EP; EP E{V, HB, sbl, a.in[5], a.in[6], HB, PSTB, red, D, ALPHA, 1.f, 0}; GEMM_PHASE_S(EP, MIX, Wout, T, D, D, E, PSTA, 0, nullptr, nullptr); }
    xcd_barrier(bar);
    REP(REP_WQ) { pg8::EpiStoreLn E{QC, D, 4, C2_X, sbl, cbl, 0}; GEMM_PHASE_S(pg8::EpiStoreLn, HB, Wq, T, D, D, E, PSTB, 0, CS + WQ_OFF, BW + WQ_OFF); }
    xcd_barrier(bar);
    REP(REP_XA) { TIDS(); xa::xa_phase(QC, KC, VCT, OC, lds, bx, G, tid, lane, wave); }
    xcd_barrier(bar);
    { typedef pg8::EpiResidS<1, true> EP; EP E{V, HB, sbl, a.in[17], a.in[18], HB, PSTA, red, D, ALPHA, 1.f, 0}; GEMM_PHASE_S(EP, OC, Wo, T, D, D, E, PSTB, 0, nullptr, nullptr); }
    xcd_barrier(bar);
    { pg8::EpiSwigluLn E{Hh, FH, sbl, cbl, 0}; GEMM_PHASE_S(pg8::EpiSwigluLn, HB, Wgu2, T, 2 * FH, D, E, PSTA, 0, CS + GU2_OFF, BW + GU2_OFF); }
    xcd_barrier(bar);
    { typedef pg8::EpiResidS<1, false> EP; EP E{V, HB, sbl, a.in[22], a.in[23], nullptr, nullptr, red, D, ALPHA, 0.5f, 0}; GEMM_PHASE_S(EP, Hh, Wd2, T, D, FH, E, PSTA, 0, nullptr, nullptr); }
    xcd_barrier(bar);
    { TIDS(); ln_pass<true>(V, a.in[27], a.in[28], nullptr, nullptr, gw, NGW, lane); }
}

extern "C" void kernel_launch(void* const* d_in, const int* in_sizes, int n_in, void* d_out, int out_size, void* d_ws, size_t ws_size, hipStream_t stream) {
    static int grid = 0;
    if (grid == 0) {
        if (n_in != 29 || out_size != T * D || ws_size < WS_END) { fprintf(stderr, "kernel_launch: unexpected shapes (n_in %d out %d ws %zu)\n", n_in, out_size, ws_size); grid = -1; return; }
        int dev = 0, cus = 0, per_cu = 0;
        hipGetDevice(&dev); hipDeviceGetAttribute(&cus, hipDeviceAttributeMultiprocessorCount, dev);
        hipFuncSetAttribute((const void*)mk_fwd, hipFuncAttributeMaxDynamicSharedMemorySize, LDS_BYTES);
        if (hipOccupancyMaxActiveBlocksPerMultiprocessor(&per_cu, (const void*)mk_fwd, 512, LDS_BYTES) != hipSuccess || per_cu < 1) per_cu = 1;
        (void)hipGetLastError();
        grid = cus * 1;
    }
    if (grid < 0) return;
    if (hipMemsetAsync((char*)d_ws + WS_CTL, 0, 16384, stream) != hipSuccess) { fprintf(stderr, "kernel_launch: memset failed\n"); return; }
    Args a{};
    for (int i = 0; i < 29; ++i) a.in[i] = (const float*)d_in[i];
    a.out = (float*)d_out; a.ws = (unsigned char*)d_ws;
    void* args[] = {&a};
    hipError_t e = hipLaunchCooperativeKernel((const void*)mk_fwd, dim3(grid), dim3(512), args, LDS_BYTES, stream);
    if (e != hipSuccess) fprintf(stderr, "cooperative launch failed: %s (grid %d)\n", hipGetErrorString(e), grid);
}
```

```cpp
#include <hip/hip_runtime.h>
#include <hip/hip_cooperative_groups.h>
#include <cstdio>
#include <cstdint>
#include <cmath>
namespace cg = cooperative_groups;

namespace pg8 {
#define PG8_LAS __attribute__((address_space(3)))
typedef unsigned short bf16_t;
typedef short bf16x8 __attribute__((ext_vector_type(8)));
typedef float f32x4 __attribute__((ext_vector_type(4)));
typedef unsigned u32x4 __attribute__((ext_vector_type(4)));
constexpr int BM = 256, BK = 64, HALF = 128, HTB = HALF * BK * 2  , STAGE_BYTES = 8 * HTB, NXCD = 8, WGM = 8;

__host__ __device__ __forceinline__ int lds_byte(int r, int c) { const int st = (r >> 4) * 2 + (c >> 5), rr = r & 15, cc = c & 31, ob = rr * 64 + cc * 2; return st * 1024 + (ob ^ (((ob >> 9) & 1) << 5)); }
__host__ __device__ __forceinline__ void stage_rc(int b, int& R, int& C) { const int st = b / 1024, sb = b % 1024, swz = sb ^ (((sb >> 9) & 1) << 5); R = (st >> 1) * 16 + swz / 64; C = (st & 1) * 32 + (swz % 64) / 2; }
__host__ __device__ __forceinline__ int perm32(int rho) { const int n = rho >> 4, i = rho & 15; return 8 * (i >> 2) + 4 * n + (i & 3); }

struct Unit { int pm, pn; };
struct Gemm { const bf16_t* A; const bf16_t* Bt; int M, N, K; };

struct StaticOrder {
    int nM, nN, nwg, G, c;
    __host__ __device__ void init(int M, int N, int G_, int c_) { nM = M / BM; nN = N / BM; nwg = nM * nN; G = G_; c = c_; }
    __host__ __device__ bool next(int i, Unit& u) const {
        const long L = (long)i * G + c; if (L >= nwg) return false;
        int wgid = (int)L; { const int q = nwg / NXCD, r = nwg % NXCD, xcd = wgid % NXCD, off = wgid / NXCD; wgid = (xcd < r ? xcd * (q + 1) : r * (q + 1) + (xcd - r) * q) + off; }
        const int nig = WGM * nN, gid = wgid / nig, fm = gid * WGM, gsz = (nM - fm) < WGM ? (nM - fm) : WGM;
        u.pm = fm + ((wgid % nig) % gsz); u.pn = (wgid % nig) / gsz; return true;
    }
    __device__ __forceinline__ void a_ready(const Unit&) const {}
    __device__ __forceinline__ void done(const Unit&) const {}
};

__device__ __forceinline__ unsigned cvt_pk_bf16(float lo, float hi) { unsigned r; asm volatile("v_cvt_pk_bf16_f32 %0, %1, %2" : "=v"(r) : "v"(lo), "v"(hi)); return r; }

struct EpiStore {
    static constexpr bool PERM = true, AFTER_DRAIN = false;
    bf16_t* O; int ldc; int nscale; float scale0;
    __device__ __forceinline__ void operator()(const f32x4 (&acc)[2][2][4][2], const Unit& u, int wr, int wc, int fr, int fq) const {
        const int row0 = u.pm * BM + wr * 64 + fr, col0 = u.pn * BM + wc * 32 + 8 * fq;
        const float sc = (u.pn < nscale) ? scale0 : 1.f;
#pragma unroll
        for (int ai = 0; ai < 2; ++ai)
#pragma unroll
            for (int m = 0; m < 4; ++m) { bf16_t* rowp = O + (size_t)(row0 + ai * HALF + m * 16) * ldc + col0;
#pragma unroll
                for (int bj = 0; bj < 2; ++bj) { const f32x4 v0 = acc[ai][bj][m][0] * sc, v1 = acc[ai][bj][m][1] * sc;
                    u32x4 w; w.x = cvt_pk_bf16(v0[0], v0[1]); w.y = cvt_pk_bf16(v0[2], v0[3]); w.z = cvt_pk_bf16(v1[0], v1[1]); w.w = cvt_pk_bf16(v1[2], v1[3]);
                    *(u32x4*)(rowp + bj * HALF) = w; } }
    }
};
__device__ __forceinline__ float silu_f(float g) { return g * __builtin_amdgcn_rcpf(1.f + __builtin_amdgcn_exp2f(-1.4426950408889634f * g)); }
struct EpiSwiglu {
    static constexpr bool PERM = true, AFTER_DRAIN = false;
    bf16_t* O; int ldc;
    __device__ __forceinline__ void operator()(const f32x4 (&acc)[2][2][4][2], const Unit& u, int wr, int wc, int fr, int fq) const {
        const int row0 = u.pm * BM + wr * 64 + fr, col0 = u.pn * HALF + wc * 32 + 8 * fq;
#pragma unroll
        for (int ai = 0; ai < 2; ++ai)
#pragma unroll
            for (int m = 0; m < 4; ++m) { bf16_t* rowp = O + (size_t)(row0 + ai * HALF + m * 16) * ldc + col0;
                float h[8];
#pragma unroll
                for (int n = 0; n < 2; ++n)
#pragma unroll
                    for (int j = 0; j < 4; ++j) h[n * 4 + j] = silu_f(acc[ai][0][m][n][j]) * acc[ai][1][m][n][j];
                u32x4 w; w.x = cvt_pk_bf16(h[0], h[1]); w.y = cvt_pk_bf16(h[2], h[3]); w.z = cvt_pk_bf16(h[4], h[5]); w.w = cvt_pk_bf16(h[6], h[7]);
                *(u32x4*)rowp = w; }
    }
};
template <int MODE> struct EpiResid {
    static constexpr bool PERM = false, AFTER_DRAIN = false;
    float* V; const float* X; const float* stats; const float* g; const float* b; int ldc; float alpha, scale;
    __device__ __forceinline__ void operator()(const f32x4 (&acc)[2][2][4][2], const Unit& u, int wr, int wc, int fr, int fq) const {
        const int row0 = u.pm * BM + wr * 64 + fr, col0 = u.pn * BM + wc * 32 + 4 * fq;
#pragma unroll
        for (int ai = 0; ai < 2; ++ai)
#pragma unroll
            for (int m = 0; m < 4; ++m) { const int row = row0 + ai * HALF + m * 16; const size_t off = (size_t)row * ldc + col0;
                float mean = 0.f, rstd = 1.f;
                if (MODE == 1) { mean = stats[2 * row]; rstd = stats[2 * row + 1]; }
#pragma unroll
                for (int bj = 0; bj < 2; ++bj)
#pragma unroll
                    for (int n = 0; n < 2; ++n) {
                        f32x4 r;
                        if (MODE == 0) r = *(const f32x4*)(X + off + bj * HALF + n * 16);
                        else { const f32x4 v = *(const f32x4*)(V + off + bj * HALF + n * 16); const f32x4 gv = *(const f32x4*)(g + col0 + bj * HALF + n * 16), bv = *(const f32x4*)(b + col0 + bj * HALF + n * 16); r = (v - mean) * rstd * gv + bv; }
                        *(f32x4*)(V + off + bj * HALF + n * 16) = r * alpha + acc[ai][bj][m][n] * scale; }
                asm volatile("" ::: "memory"); }
    }
};

constexpr float LNEPS = 1e-5f;
__device__ __forceinline__ float pg_xor16(float v) { return __int_as_float(__builtin_amdgcn_ds_swizzle(__float_as_int(v), 0x1F | (16 << 10))); }
__device__ __forceinline__ float pg_half_sum(float v) { auto rr = __builtin_amdgcn_permlane32_swap(__float_as_uint(v), __float_as_uint(v), false, false); return __uint_as_float(rr[0]) + __uint_as_float(rr[1]); }
__device__ __forceinline__ void row_stats(const float* __restrict__ PST, int row, float& mean, float& rstd) {
    const f32x4 a = *(const f32x4*)(PST + (size_t)row * 8), b = *(const f32x4*)(PST + (size_t)row * 8 + 4);
    const float s = (a.x + a.z) + (b.x + b.z), q = (a.y + a.w) + (b.y + b.w);
    mean = s * (1.f / 1024.f); const float var = fmaxf(q * (1.f / 1024.f) - mean * mean, 0.f); rstd = 1.f / sqrtf(var + LNEPS);
}
struct StatsOrder : StaticOrder {
    const float* PST; PG8_LAS unsigned char* sbuf; int by_pn; const float* cs; const float* bw; PG8_LAS unsigned char* cbuf; mutable int k;
    __device__ __forceinline__ void a_ready(const Unit& u) const {
        const int tid = threadIdx.x, wid = __builtin_amdgcn_readfirstlane(tid >> 6);
        const float* gp = PST + (size_t)((by_pn ? u.pn : u.pm) * BM + (tid >> 1)) * 8 + (tid & 1) * 4;
        __builtin_amdgcn_global_load_lds((const unsigned*)gp, (PG8_LAS unsigned*)(sbuf + (k & 1) * 8192 + wid * 1024), 16, 0, 0);
        if (cs != nullptr && wid < 2) {
            const float* cp = (wid == 0 ? cs : bw) + (by_pn ? u.pm : u.pn) * BM + (tid & 63) * 4;
            __builtin_amdgcn_global_load_lds((const unsigned*)cp, (PG8_LAS unsigned*)(cbuf + (k & 1) * 2048 + wid * 1024), 16, 0, 0);
        }
        ++k;
    }
};
__device__ __forceinline__ void row_stats_lds(const PG8_LAS float* sb, int rl, float& mean, float& rstd) {
    const f32x4 a = *(const PG8_LAS f32x4*)(sb + rl * 8), b = *(const PG8_LAS f32x4*)(sb + rl * 8 + 4);
    const float s = (a.x + a.z) + (b.x + b.z), q = (a.y + a.w) + (b.y + b.w);
    mean = s * (1.f / 1024.f); const float var = fmaxf(q * (1.f / 1024.f) - mean * mean, 0.f); rstd = __builtin_amdgcn_rsqf(var + LNEPS);
}
struct EpiStoreLn {
    static constexpr bool PERM = true, AFTER_DRAIN = false;
    bf16_t* O; int ldc; int nscale; float scale0; const PG8_LAS float* sbuf; const PG8_LAS float* cbuf; mutable int k;
    __device__ __forceinline__ void operator()(const f32x4 (&acc)[2][2][4][2], const Unit& u, int wr, int wc, int fr, int fq) const {
        const int row0 = u.pm * BM + wr * 64 + fr, col0 = u.pn * BM + wc * 32 + 8 * fq;
        const PG8_LAS float* sb = sbuf + (k & 1) * 2048; const PG8_LAS float* cb = cbuf + (k & 1) * 512 + wc * 32 + 8 * fq; ++k;
        const float sc = (u.pn < nscale) ? scale0 : 1.f;
        f32x4 c4[2][2], b4[2][2];
#pragma unroll
        for (int bj = 0; bj < 2; ++bj)
#pragma unroll
            for (int n = 0; n < 2; ++n) { c4[bj][n] = *(const PG8_LAS f32x4*)(cb + bj * HALF + 4 * n); b4[bj][n] = *(const PG8_LAS f32x4*)(cb + 256 + bj * HALF + 4 * n); }
#pragma unroll
        for (int ai = 0; ai < 2; ++ai)
#pragma unroll
            for (int m = 0; m < 4; ++m) { const int row = row0 + ai * HALF + m * 16; bf16_t* rowp = O + (size_t)row * ldc + col0;
                float mean, rstd; row_stats_lds(sb, ai * HALF + wr * 64 + m * 16 + fr, mean, rstd); const float mr = mean * rstd;
#pragma unroll
                for (int bj = 0; bj < 2; ++bj) { const f32x4 v0 = (acc[ai][bj][m][0] * rstd - c4[bj][0] * mr + b4[bj][0]) * sc, v1 = (acc[ai][bj][m][1] * rstd - c4[bj][1] * mr + b4[bj][1]) * sc;
                    u32x4 w; w.x = cvt_pk_bf16(v0[0], v0[1]); w.y = cvt_pk_bf16(v0[2], v0[3]); w.z = cvt_pk_bf16(v1[0], v1[1]); w.w = cvt_pk_bf16(v1[2], v1[3]);
                    *(u32x4*)(rowp + bj * HALF) = w; } }
    }
};
struct EpiStoreLnT {
    static constexpr bool PERM = true, AFTER_DRAIN = false;
    bf16_t* O; int ldc; const PG8_LAS float* sbuf; const PG8_LAS float* cbuf; mutable int k;
    __device__ __forceinline__ void operator()(const f32x4 (&acc)[2][2][4][2], const Unit& u, int wr, int wc, int fr, int fq) const {
        const int row0 = u.pm * BM + wr * 64 + fr, col0 = u.pn * BM + wc * 32 + 8 * fq;
        const PG8_LAS float* sb = sbuf + (k & 1) * 2048; const PG8_LAS float* cb = cbuf + (k & 1) * 512 + wr * 64 + fr; ++k;
        float tr[2][8], tmr[2][8];
#pragma unroll
        for (int bj = 0; bj < 2; ++bj)
#pragma unroll
            for (int e = 0; e < 8; ++e) { float mean, rstd; row_stats_lds(sb, wc * 32 + 8 * fq + bj * HALF + e, mean, rstd); tr[bj][e] = rstd; tmr[bj][e] = mean * rstd; }
#pragma unroll
        for (int ai = 0; ai < 2; ++ai)
#pragma unroll
            for (int m = 0; m < 4; ++m) { const int row = row0 + ai * HALF + m * 16; bf16_t* rowp = O + (size_t)row * ldc + col0; const float c = cb[ai * HALF + m * 16], b = cb[256 + ai * HALF + m * 16];
#pragma unroll
                for (int bj = 0; bj < 2; ++bj) { float v[8];
#pragma unroll
                    for (int e = 0; e < 8; ++e) v[e] = acc[ai][bj][m][e >> 2][e & 3] * tr[bj][e] - c * tmr[bj][e] + b;
                    u32x4 w; w.x = cvt_pk_bf16(v[0], v[1]); w.y = cvt_pk_bf16(v[2], v[3]); w.z = cvt_pk_bf16(v[4], v[5]); w.w = cvt_pk_bf16(v[6], v[7]);
                    *(u32x4*)(rowp + bj * HALF) = w; } }
    }
};
struct EpiSwigluLn {
    static constexpr bool PERM = true, AFTER_DRAIN = false;
    bf16_t* O; int ldc; const PG8_LAS float* sbuf; const PG8_LAS float* cbuf; mutable int k;
    __device__ __forceinline__ void operator()(const f32x4 (&acc)[2][2][4][2], const Unit& u, int wr, int wc, int fr, int fq) const {
        const int row0 = u.pm * BM + wr * 64 + fr, col0 = u.pn * HALF + wc * 32 + 8 * fq;
        const PG8_LAS float* sb = sbuf + (k & 1) * 2048; const PG8_LAS float* cb = cbuf + (k & 1) * 512 + wc * 32 + 8 * fq; ++k;
        f32x4 c4[2][2], b4[2][2];
#pragma unroll
        for (int bj = 0; bj < 2; ++bj)
#pragma unroll
            for (int n = 0; n < 2; ++n) { c4[bj][n] = *(const PG8_LAS f32x4*)(cb + bj * HALF + 4 * n); b4[bj][n] = *(const PG8_LAS f32x4*)(cb + 256 + bj * HALF + 4 * n); }
#pragma unroll
        for (int ai = 0; ai < 2; ++ai)
#pragma unroll
            for (int m = 0; m < 4; ++m) { const int row = row0 + ai * HALF + m * 16; bf16_t* rowp = O + (size_t)row * ldc + col0;
                float mean, rstd; row_stats_lds(sb, ai * HALF + wr * 64 + m * 16 + fr, mean, rstd); const float mr = mean * rstd;
                float h[8];
#pragma unroll
                for (int n = 0; n < 2; ++n) { const f32x4 gt = acc[ai][0][m][n] * rstd - c4[0][n] * mr + b4[0][n], up = acc[ai][1][m][n] * rstd - c4[1][n] * mr + b4[1][n];
#pragma unroll
                    for (int j = 0; j < 4; ++j) h[n * 4 + j] = silu_f(gt[j]) * up[j]; }
                u32x4 w; w.x = cvt_pk_bf16(h[0], h[1]); w.y = cvt_pk_bf16(h[2], h[3]); w.z = cvt_pk_bf16(h[4], h[5]); w.w = cvt_pk_bf16(h[6], h[7]);
                *(u32x4*)rowp = w; }
    }
};
template <int MODE, bool STATS> struct EpiResidS {
    static constexpr bool PERM = false, AFTER_DRAIN = false;
    float* V; const bf16_t* RB; const PG8_LAS float* sbuf; const float* g; const float* b; bf16_t* VB; float* PSTout; PG8_LAS float* red; int ldc; float alpha, scale; mutable int k;
    __device__ __forceinline__ void operator()(const f32x4 (&acc)[2][2][4][2], const Unit& u, int wr, int wc, int fr, int fq) const {
        typedef unsigned u32x2 __attribute__((ext_vector_type(2)));
        const int row0 = u.pm * BM + wr * 64 + fr, col0 = u.pn * BM + wc * 32 + 4 * fq;
        const PG8_LAS float* sb = sbuf + (k & 1) * 2048; ++k;
#pragma unroll
        for (int ai = 0; ai < 2; ++ai) {
            u32x2 rv[4][2][2];
#pragma unroll
            for (int m = 0; m < 4; ++m) { const unsigned off = (unsigned)((row0 + ai * HALF + m * 16) * ldc + col0);
#pragma unroll
                for (int bj = 0; bj < 2; ++bj)
#pragma unroll
                    for (int n = 0; n < 2; ++n) rv[m][bj][n] = *(const u32x2*)(RB + off + bj * HALF + n * 16); }
            f32x4 gv[2][2], bv[2][2];
            if (MODE == 1) {
#pragma unroll
                for (int bj = 0; bj < 2; ++bj)
#pragma unroll
                    for (int n = 0; n < 2; ++n) { gv[bj][n] = *(const f32x4*)(g + col0 + bj * HALF + n * 16); bv[bj][n] = *(const f32x4*)(b + col0 + bj * HALF + n * 16); }
            }
#pragma unroll
            for (int m = 0; m < 4; ++m) { const unsigned off = (unsigned)((row0 + ai * HALF + m * 16) * ldc + col0);
                float mean = 0.f, rstd = 1.f;
                if (MODE == 1) row_stats_lds(sb, ai * HALF + wr * 64 + m * 16 + fr, mean, rstd);
                float s = 0.f, q = 0.f;
#pragma unroll
                for (int bj = 0; bj < 2; ++bj)
#pragma unroll
                    for (int n = 0; n < 2; ++n) {
                        const u32x2 rw = rv[m][bj][n];
                        f32x4 r = {__uint_as_float(rw.x << 16), __uint_as_float(rw.x & 0xffff0000u), __uint_as_float(rw.y << 16), __uint_as_float(rw.y & 0xffff0000u)};
                        if (MODE == 1) r = (r - mean) * rstd * gv[bj][n] + bv[bj][n];
                        const f32x4 o = r * alpha + acc[ai][bj][m][n] * scale;
                        if (STATS) { s += (o[0] + o[1]) + (o[2] + o[3]); q += (o[0] * o[0] + o[1] * o[1]) + (o[2] * o[2] + o[3] * o[3]);
                            u32x2 w; w.x = cvt_pk_bf16(o[0], o[1]); w.y = cvt_pk_bf16(o[2], o[3]); *(u32x2*)(VB + off + bj * HALF + n * 16) = w; }
                        else *(f32x4*)(V + off + bj * HALF + n * 16) = o; }
                if (STATS) { s += pg_xor16(s); q += pg_xor16(q); s = pg_half_sum(s); q = pg_half_sum(q);
                    if (fq == 0) { PG8_LAS float* rp = red + (ai * HALF + wr * 64 + m * 16 + fr) * 8 + wc * 2; rp[0] = s; rp[1] = q; } } }
            asm volatile("" ::: "memory");
        }
        if (STATS) {
            asm volatile("s_waitcnt lgkmcnt(0)" ::: "memory"); __builtin_amdgcn_s_barrier(); asm volatile("" ::: "memory");
            const int t = (wr * 4 + wc) * 64 + fq * 16 + fr, rl = t >> 1, wh = t & 1;
            const PG8_LAS float* rp = red + rl * 8 + wh;
            PSTout[(size_t)(u.pm * BM + rl) * 8 + u.pn * 2 + wh] = (rp[0] + rp[2]) + (rp[4] + rp[6]);
        }
    }
};

template <class Epi, class Sched, bool ALIGN_EPI = false, bool SP2 = false>
__device__ __forceinline__ void gemm_phase(PG8_LAS unsigned char* lds, const Gemm g, const Sched& S, const Epi& E) {
    int tid_ = threadIdx.x; asm volatile("" : "+v"(tid_));
    const int tid = tid_, wid = __builtin_amdgcn_readfirstlane(tid >> 6), lane = tid & 63, wr = wid >> 2, wc = wid & 3, fr = lane & 15, fq = lane >> 4;
    const int K = g.K, nt = K / BK;
    unsigned voffA[2], voffB[2];
#pragma unroll
    for (int i = 0; i < 2; ++i) { int R, C; stage_rc(tid * 16 + i * 8192, R, C); const int Rb = Epi::PERM ? ((R & ~31) + perm32(R & 31)) : R;
        voffA[i] = (unsigned)(R * K + C) * 2u; voffB[i] = (unsigned)(Rb * K + C) * 2u; }
    const size_t kstep = (size_t)(BK * 2);
    const size_t hstep = (size_t)HALF * K * 2;
    const size_t tstep = 2 * hstep;
    const unsigned ldsw = (unsigned)wid * 1024u;
    const int aoff = lds_byte(wr * 64 + fr, fq * 8), boff = lds_byte(wc * 32 + fr, fq * 8);
#define PG8_SA(b, h) (((b) * 2 + (h)) * HTB)
#define PG8_SB(b, h) ((4 + (b) * 2 + (h)) * HTB)
#define PG8_STAGE(bufoff, gbase, voff) do { _Pragma("unroll") for (int _i = 0; _i < 2; ++_i) \
        __builtin_amdgcn_global_load_lds((const unsigned*)((const char*)(gbase) + (voff)[_i]), (PG8_LAS unsigned*)(lds + (bufoff) + ldsw + _i * 8192), 16, 0, 0); } while (0)
#define PG8_LDA(dst, b, h) do { _Pragma("unroll") for (int m = 0; m < 4; ++m) _Pragma("unroll") for (int k = 0; k < 2; ++k) dst[m][k] = *(const PG8_LAS bf16x8*)(lds + PG8_SA(b, h) + aoff + m * 2048 + k * 1024); } while (0)
#define PG8_LDB(dst, b, h) do { _Pragma("unroll") for (int n = 0; n < 2; ++n) _Pragma("unroll") for (int k = 0; k < 2; ++k) dst[n][k] = *(const PG8_LAS bf16x8*)(lds + PG8_SB(b, h) + boff + n * 2048 + k * 1024); } while (0)
#define PG8_MMA(ai, bj, At, Bt) do { __builtin_amdgcn_s_setprio(1); _Pragma("unroll") for (int m = 0; m < 4; ++m) _Pragma("unroll") for (int n = 0; n < 2; ++n) _Pragma("unroll") for (int k = 0; k < 2; ++k) \
        acc[ai][bj][m][n] = __builtin_amdgcn_mfma_f32_16x16x32_bf16(Bt[n][k], At[m][k], acc[ai][bj][m][n], 0, 0, 0); __builtin_amdgcn_s_setprio(0); } while (0)
#define PG8_WAIT_V(n) asm volatile("s_waitcnt vmcnt(" #n ")" ::: "memory")
#define PG8_WAIT_L(n) asm volatile("s_waitcnt lgkmcnt(" #n ")" ::: "memory")
#define PG8_BAR __builtin_amdgcn_s_barrier()
#define PG8_SCHED __builtin_amdgcn_sched_barrier(0)
    Unit cur, nxt; int ui = 0;
    if (!S.next(0, cur)) return;
    f32x4 acc[2][2][4][2];
#pragma unroll
    for (int a = 0; a < 2; ++a)
#pragma unroll
        for (int b = 0; b < 2; ++b)
#pragma unroll
            for (int m = 0; m < 4; ++m)
#pragma unroll
                for (int n = 0; n < 2; ++n) acc[a][b][m][n] = (f32x4){0.f, 0.f, 0.f, 0.f};
    bf16x8 At[4][2], B0[2][2], B1[2][2];
    const char* cA = (const char*)g.A + (size_t)cur.pm * tstep; const char* cB = (const char*)g.Bt + (size_t)cur.pn * tstep;
    S.a_ready(cur);
    if constexpr (SP2) {
        PG8_STAGE(PG8_SB(0, 0), cB, voffB); PG8_STAGE(PG8_SB(0, 1), cB + hstep, voffB); PG8_STAGE(PG8_SA(0, 0), cA, voffA); PG8_STAGE(PG8_SA(0, 1), cA + hstep, voffA);
        if (wr == 1) PG8_BAR;
        PG8_WAIT_V(2); PG8_BAR;
        PG8_STAGE(PG8_SB(1, 0), cB + kstep, voffB); PG8_STAGE(PG8_SA(1, 0), cA + kstep, voffA); PG8_STAGE(PG8_SB(1, 1), cB + hstep + kstep, voffB);
        PG8_WAIT_V(6); PG8_BAR;
    } else {
        PG8_STAGE(PG8_SB(0, 0), cB, voffB); PG8_STAGE(PG8_SA(0, 0), cA, voffA); PG8_STAGE(PG8_SB(0, 1), cB + hstep, voffB); PG8_STAGE(PG8_SA(0, 1), cA + hstep, voffA);
        if (wr == 1) PG8_BAR;
        PG8_WAIT_V(4); PG8_BAR;
        PG8_STAGE(PG8_SB(1, 0), cB + kstep, voffB); PG8_STAGE(PG8_SA(1, 0), cA + kstep, voffA); PG8_STAGE(PG8_SB(1, 1), cB + hstep + kstep, voffB);
        PG8_WAIT_V(6); PG8_BAR;
    }
    for (;;) {
        const bool has_next = S.next(ui + 1, nxt);
        const char* nA = has_next ? (const char*)g.A + (size_t)nxt.pm * tstep : cA; const char* nB = has_next ? (const char*)g.Bt + (size_t)nxt.pn * tstep : cB;
        for (int t = 0; t < nt; t += 2) {
            const bool last = (t == nt - 2);
            const char* a1 = cA + (size_t)(t + 1) * kstep;
            const char* a2 = last ? nA : cA + (size_t)(t + 2) * kstep; const char* b2 = last ? nB : cB + (size_t)(t + 2) * kstep;
            const char* a3 = a2 + kstep; const char* b3 = b2 + kstep;
            if (last && has_next) S.a_ready(nxt);
            if constexpr (SP2) {
            PG8_LDB(B0, 0, 0); PG8_LDB(B1, 0, 1); PG8_SCHED; PG8_LDA(At, 0, 0); PG8_STAGE(PG8_SA(1, 1), a1 + hstep, voffA);
            PG8_WAIT_V(8); PG8_WAIT_L(0); PG8_BAR; PG8_MMA(0, 0, At, B0); PG8_MMA(0, 1, At, B1); PG8_BAR; PG8_SCHED;
            PG8_LDA(At, 0, 1); PG8_STAGE(PG8_SB(0, 0), b2, voffB); PG8_STAGE(PG8_SB(0, 1), b2 + hstep, voffB); PG8_STAGE(PG8_SA(0, 0), a2, voffA);
            PG8_WAIT_V(8); PG8_WAIT_L(0); PG8_BAR; PG8_MMA(1, 0, At, B0); PG8_MMA(1, 1, At, B1); PG8_BAR; PG8_SCHED;
            PG8_LDB(B0, 1, 0); PG8_LDB(B1, 1, 1); PG8_SCHED; PG8_LDA(At, 1, 0); PG8_STAGE(PG8_SA(0, 1), a2 + hstep, voffA);
            PG8_WAIT_V(8); PG8_WAIT_L(0); PG8_BAR; PG8_MMA(0, 0, At, B0); PG8_MMA(0, 1, At, B1); PG8_BAR; PG8_SCHED;
            PG8_LDA(At, 1, 1); PG8_STAGE(PG8_SB(1, 0), b3, voffB); PG8_STAGE(PG8_SB(1, 1), b3 + hstep, voffB); PG8_STAGE(PG8_SA(1, 0), a3, voffA);
            PG8_WAIT_V(8); PG8_WAIT_L(0); PG8_BAR; PG8_MMA(1, 0, At, B0); PG8_MMA(1, 1, At, B1); PG8_BAR; PG8_SCHED;
            } else {
            PG8_LDB(B0, 0, 0); PG8_SCHED; PG8_LDA(At, 0, 0); PG8_STAGE(PG8_SA(1, 1), a1 + hstep, voffA);
            PG8_WAIT_L(8); PG8_BAR; PG8_WAIT_L(0); PG8_MMA(0, 0, At, B0); PG8_BAR; PG8_SCHED;
            PG8_LDB(B1, 0, 1); PG8_STAGE(PG8_SB(0, 0), b2, voffB);
            PG8_BAR; PG8_WAIT_L(0); PG8_MMA(0, 1, At, B1); PG8_BAR;
            PG8_LDA(At, 0, 1); PG8_STAGE(PG8_SA(0, 0), a2, voffA);
            PG8_BAR; PG8_WAIT_L(0); PG8_MMA(1, 0, At, B0); PG8_BAR; PG8_SCHED;
            PG8_STAGE(PG8_SB(0, 1), b2 + hstep, voffB);
            PG8_WAIT_V(6); PG8_BAR; PG8_MMA(1, 1, At, B1); PG8_BAR;
            PG8_LDB(B0, 1, 0); PG8_SCHED; PG8_LDA(At, 1, 0); PG8_STAGE(PG8_SA(0, 1), a2 + hstep, voffA);
            PG8_WAIT_L(8); PG8_BAR; PG8_WAIT_L(0); PG8_MMA(0, 0, At, B0); PG8_BAR; PG8_SCHED;
            PG8_LDB(B1, 1, 1); PG8_STAGE(PG8_SB(1, 0), b3, voffB);
            PG8_BAR; PG8_WAIT_L(0); PG8_MMA(0, 1, At, B1); PG8_BAR;
            PG8_LDA(At, 1, 1); PG8_STAGE(PG8_SA(1, 0), a3, voffA);
            PG8_BAR; PG8_WAIT_L(0); PG8_MMA(1, 0, At, B0); PG8_BAR; PG8_SCHED;
            PG8_STAGE(PG8_SB(1, 1), b3 + hstep, voffB);
            PG8_WAIT_V(6); PG8_BAR; PG8_MMA(1, 1, At, B1); PG8_BAR;
            }
        }
        if constexpr (ALIGN_EPI) { if (wr == 0) PG8_BAR; }
        if constexpr (!Epi::AFTER_DRAIN) { E(acc, cur, wr, wc, fr, fq); S.done(cur); }
        if (!has_next) break;
#pragma unroll
        for (int a = 0; a < 2; ++a)
#pragma unroll
            for (int b = 0; b < 2; ++b)
#pragma unroll
                for (int m = 0; m < 4; ++m)
#pragma unroll
                    for (int n = 0; n < 2; ++n) acc[a][b][m][n] = (f32x4){0.f, 0.f, 0.f, 0.f};
        cur = nxt; cA = nA; cB = nB; ++ui;
        if constexpr (ALIGN_EPI) { if (wr == 1) PG8_BAR; }
    }
    PG8_WAIT_V(0);
    if constexpr (!ALIGN_EPI) { if (wr == 0) PG8_BAR; }
    PG8_BAR;
    if constexpr (Epi::AFTER_DRAIN) { E.fused(acc, cur, wr, wc, fr, fq, lds, wid, lane); S.done(cur); }
#undef PG8_SA
#undef PG8_SB
#undef PG8_STAGE
#undef PG8_LDA
#undef PG8_LDB
#undef PG8_MMA
#undef PG8_WAIT_V
#undef PG8_WAIT_L
#undef PG8_BAR
#undef PG8_SCHED
}
}
constexpr int D = 1024, BATCH = 8, SEQ = 4096, T = BATCH * SEQ, FH = 2816, MEM = 256, TM = BATCH * MEM;
constexpr int NIN = 2816;
constexpr int QD = 0, KD = 512, QG = 1024, KG = 1280, VG = 1536, RG = 2048, GL = 2560;
constexpr int WIN_ROWS = 3328, VDROW = 2816;
constexpr float ALPHA = 1.189207115002721f;
constexpr float LN_EPS = 1e-5f;
constexpr float LOG2E = 1.4426950408889634f;
constexpr float C2_DA = 0.125f * LOG2E;
constexpr float C2_X = 0.0625f * LOG2E;
constexpr float LAMBDA_INIT = 0.2f;

constexpr size_t MiB = 1u << 20;
constexpr size_t WS_GU1 = 0, WS_D1 = 11 * MiB, WS_WIN = 17 * MiB, WS_WOUT = 24 * MiB, WS_WQ = 26 * MiB, WS_WKV = 28 * MiB, WS_WO = 32 * MiB, WS_GU2 = 34 * MiB, WS_D2 = 45 * MiB;
constexpr size_t WS_MB = 51 * MiB, WS_KVC = 55 * MiB, WS_STATS = 63 * MiB;
constexpr size_t WS_XB = 64 * MiB;
constexpr size_t WS_HB = 128 * MiB;
constexpr size_t WS_R1 = 192 * MiB;
constexpr size_t WS_DS = 400 * MiB;
constexpr size_t WS_DEC = 464 * MiB;
constexpr size_t WS_VT = 465 * MiB;
constexpr size_t WS_CTL = 497 * MiB;
constexpr size_t WS_PSTA = 498 * MiB, WS_PSTB = 499 * MiB;
constexpr size_t WS_PARTC = 500 * MiB, WS_PARTB = 501 * MiB;
constexpr size_t WS_CS = 502 * MiB, WS_BW = 502 * MiB + 512 * 1024;
constexpr size_t WS_END = 503 * MiB;
constexpr int LDS_BYTES = 157696;

typedef unsigned short bf16;
typedef unsigned v4u __attribute__((ext_vector_type(4)));
typedef unsigned v2u __attribute__((ext_vector_type(2)));
typedef float f32x4 __attribute__((ext_vector_type(4)));
#define LAS __attribute__((address_space(3)))

__device__ __forceinline__ unsigned f2bf(float f) { unsigned u = __builtin_bit_cast(unsigned, f); return (u + 0x7fffu + ((u >> 16) & 1u)) >> 16; }
__device__ __forceinline__ unsigned pk2(float lo, float hi) { return f2bf(lo) | (f2bf(hi) << 16); }
__device__ __forceinline__ float bf2f(bf16 u) { return __uint_as_float((unsigned)u << 16); }
__device__ __forceinline__ float bflo(unsigned w) { return __uint_as_float(w << 16); }
__device__ __forceinline__ float bfhi(unsigned w) { return __uint_as_float(w & 0xffff0000u); }
template <int O> __device__ __forceinline__ float swz_xor(float v) { return __int_as_float(__builtin_amdgcn_ds_swizzle(__float_as_int(v), 0x1F | (O << 10))); }
__device__ __forceinline__ float half_sum(float v) { auto rr = __builtin_amdgcn_permlane32_swap(__float_as_uint(v), __float_as_uint(v), false, false); return __uint_as_float(rr[0]) + __uint_as_float(rr[1]); }
__device__ __forceinline__ float half_max(float v) { auto rr = __builtin_amdgcn_permlane32_swap(__float_as_uint(v), __float_as_uint(v), false, false); return fmaxf(__uint_as_float(rr[0]), __uint_as_float(rr[1])); }
__device__ __forceinline__ float sum32(float v) { v += swz_xor<1>(v); v += swz_xor<2>(v); v += swz_xor<4>(v); v += swz_xor<8>(v); v += swz_xor<16>(v); return v; }
__device__ __forceinline__ float wave_sum(float v) { return half_sum(sum32(v)); }
__device__ __forceinline__ float wave_max(float v) { v = fmaxf(v, swz_xor<1>(v)); v = fmaxf(v, swz_xor<2>(v)); v = fmaxf(v, swz_xor<4>(v)); v = fmaxf(v, swz_xor<8>(v)); v = fmaxf(v, swz_xor<16>(v)); return half_max(v); }

constexpr int PTOT = 9984, WIN_OFF = 0, WQ_OFF = 3328, GU2_OFF = 4352;
template <bool FOLD> __device__ __forceinline__ void transpose_item(const float* __restrict__ W, int K, int N, bf16* __restrict__ WT, int k0, int n0, int drow0, float* scr, int lane,
                                                                    const float* __restrict__ g, const float* __restrict__ b, float* __restrict__ PC, float* __restrict__ PB) {
    const int nq = 4 * (lane & 15), kr = lane >> 4; const bool ok = (n0 + nq) < N;
    f32x4 v[16];
#pragma unroll
    for (int i = 0; i < 16; ++i) v[i] = ok ? *(const f32x4*)(W + (size_t)(k0 + kr + 4 * i) * N + n0 + nq) : (f32x4){0.f, 0.f, 0.f, 0.f};
#pragma unroll
    for (int i = 0; i < 16; ++i) { float* d = scr + (kr + 4 * i) * 65 + nq; d[0] = v[i].x; d[1] = v[i].y; d[2] = v[i].z; d[3] = v[i].w; }
    __builtin_amdgcn_wave_barrier(); asm volatile("s_waitcnt lgkmcnt(0)" ::: "memory");
    const int c = lane & 7;
    float gk[8], bk[8];
    if (FOLD) {
#pragma unroll
        for (int e = 0; e < 8; ++e) { gk[e] = g[k0 + 8 * c + e]; bk[e] = b[k0 + 8 * c + e]; }
    }
#pragma unroll
    for (int j = 0; j < 8; ++j) { const int n = (lane >> 3) + 8 * j; const float* s = scr + (8 * c) * 65 + n;
        float x[8];
#pragma unroll
        for (int e = 0; e < 8; ++e) x[e] = s[e * 65];
        v4u o;
        if (FOLD) {
            float ws = 0.f, bs = 0.f; unsigned h[8];
#pragma unroll
            for (int e = 0; e < 8; ++e) { h[e] = f2bf(x[e] * gk[e]); ws += __uint_as_float(h[e] << 16); bs += bk[e] * x[e]; }
            o.x = h[0] | (h[1] << 16); o.y = h[2] | (h[3] << 16); o.z = h[4] | (h[5] << 16); o.w = h[6] | (h[7] << 16);
            ws += swz_xor<1>(ws); ws += swz_xor<2>(ws); ws += swz_xor<4>(ws); bs += swz_xor<1>(bs); bs += swz_xor<2>(bs); bs += swz_xor<4>(bs);
            if (c == 0) { const size_t pi = (size_t)(k0 >> 6) * PTOT + drow0 + n; PC[pi] = ws; PB[pi] = bs; }
        } else { o.x = pk2(x[0], x[1]); o.y = pk2(x[2], x[3]); o.z = pk2(x[4], x[5]); o.w = pk2(x[6], x[7]); }
        *(v4u*)(WT + (size_t)(drow0 + n) * K + k0 + 8 * c) = o; }
    __builtin_amdgcn_wave_barrier(); asm volatile("s_waitcnt lgkmcnt(0)" ::: "memory");
}
template <int MAP, bool FOLD> __device__ __forceinline__ void transpose_matrix(const float* W, int K, int N, bf16* WT, float* scr, int gw, int NGW, int lane,
                                                                               const float* g = nullptr, const float* b = nullptr, float* PC = nullptr, float* PB = nullptr) {
    const int nblk = (N + 63) / 64, items = (K / 64) * nblk;
    for (int it = gw; it < items; it += NGW) { const int kb = it / nblk, nb = it % nblk, n0 = 64 * nb;
        int drow0 = n0;
        if (MAP == 1 || MAP == 2) drow0 = (n0 >> 7) * 256 + (n0 & 127) + (MAP == 2 ? 128 : 0);
        if (MAP == 3) drow0 = (n0 < 1024) ? n0 : (n0 < 1536) ? VDROW + (n0 - 1024) : n0 - 512;
        transpose_item<FOLD>(W, K, N, WT, 64 * kb, n0, drow0, scr, lane, g, b, PC, PB); }
}
__device__ __forceinline__ void convert_bf16(const float* __restrict__ src, bf16* __restrict__ dst, size_t n, size_t gt, size_t NGT) {
    const size_t nch = n / 8;
    for (size_t i0 = gt; i0 < nch; i0 += 4 * NGT) {
        f32x4 a[4], b[4];
#pragma unroll
        for (int u = 0; u < 4; ++u) { const size_t i = i0 + u * NGT; if (i < nch) { a[u] = *(const f32x4*)(src + 8 * i); b[u] = *(const f32x4*)(src + 8 * i + 4); } }
#pragma unroll
        for (int u = 0; u < 4; ++u) { const size_t i = i0 + u * NGT; if (i < nch) { v4u o; o.x = pk2(a[u].x, a[u].y); o.y = pk2(a[u].z, a[u].w); o.z = pk2(b[u].x, b[u].y); o.w = pk2(b[u].z, b[u].w); *(v4u*)(dst + 8 * i) = o; } }
    }
}
template <bool FINAL> __device__ __forceinline__ void ln_pass(float* V, const float* g, const float* b, bf16* HB, float* stats, int gw, int NGW, int lane) {
    f32x4 gv[4], bv[4];
#pragma unroll
    for (int j = 0; j < 4; ++j) { gv[j] = *((const f32x4*)g + lane + 64 * j); bv[j] = *((const f32x4*)b + lane + 64 * j); }
    for (int m = gw; m < T; m += NGW) {
        f32x4* xr = (f32x4*)(V + (size_t)m * D) + lane;
        f32x4 v[4]; float s = 0.f;
#pragma unroll
        for (int j = 0; j < 4; ++j) { v[j] = xr[64 * j]; s += (v[j].x + v[j].y) + (v[j].z + v[j].w); }
        const float mean = wave_sum(s) * (1.f / D); float s2 = 0.f;
#pragma unroll
        for (int j = 0; j < 4; ++j) { v[j] = v[j] - mean; s2 += (v[j].x * v[j].x + v[j].y * v[j].y) + (v[j].z * v[j].z + v[j].w * v[j].w); }
        const float rstd = 1.f / sqrtf(wave_sum(s2) * (1.f / D) + LN_EPS);
        if (FINAL) {
#pragma unroll
            for (int j = 0; j < 4; ++j) xr[64 * j] = v[j] * rstd * gv[j] + bv[j];
        } else {
            v2u* o8 = (v2u*)(HB + (size_t)m * D) + lane;
#pragma unroll
            for (int j = 0; j < 4; ++j) { const f32x4 y = v[j] * rstd * gv[j] + bv[j]; v2u o; o.x = pk2(y.x, y.y); o.y = pk2(y.z, y.w); o8[64 * j] = o; }
            if (lane == 0) { stats[2 * m] = mean; stats[2 * m + 1] = rstd; }
        }
    }
}

namespace da {
typedef short bf16x8 __attribute__((ext_vector_type(8)));
typedef float f32x16 __attribute__((ext_vector_type(16)));
constexpr int KROW = 272, VROW = 144, KBYTES = 64 * KROW, VBYTES = 128 * VROW, STAGE = KBYTES + VBYTES;
constexpr int XCH = 16384, STG_OFF = 4 * XCH, STG_BYTES = 32 * 272, NG_OFF = 3 * STAGE;
__device__ __forceinline__ int crow(int r, int hi) { return (r & 3) + 8 * (r >> 2) + 4 * hi; }
__device__ __forceinline__ unsigned pkbf(float lo, float hi) { typedef float f2 __attribute__((ext_vector_type(2))); typedef __bf16 b2 __attribute__((ext_vector_type(2))); f2 v = {lo, hi}; b2 b = __builtin_convertvector(v, b2); return __builtin_bit_cast(unsigned, b); }

__device__ __forceinline__ void da_unit(int b, int h, int qb, const bf16* __restrict__ QKV, const bf16* __restrict__ VT, bf16* __restrict__ MIX, unsigned char* lds, float lam, int tid, int lane, int wave) {
    const int c = wave >> 2, qg = wave & 3, q32 = lane & 31, hi = lane >> 5;
    const int NT = 2 * qb + 2, myT = 2 * qb + (qg >> 1);
    const size_t tokbase = (size_t)b * SEQ;
    const bf16* kg0 = QKV + (tokbase + (tid >> 4)) * NIN + KD + h * 128 + (tid & 15) * 8;
    const bf16* vg0 = VT + (size_t)(h * 128 + (tid >> 3)) * T + tokbase + (tid & 7) * 8;
    const int kl0 = (tid >> 4) * KROW + (tid & 15) * 16, vl0 = KBYTES + (tid >> 3) * VROW + ((tid & 7) >> 1) * 32 + (tid & 1) * 8;
    v4u rk[2], rv[2];
#define DA_LOAD(t) do { _Pragma("unroll") for (int i = 0; i < 2; ++i) { rk[i] = *(const v4u*)(kg0 + (size_t)((t) * 64 + i * 32) * NIN); rv[i] = *(const v4u*)(vg0 + (size_t)i * 64 * T + (t) * 64); } } while (0)
#define DA_STORE(sp) do { _Pragma("unroll") for (int i = 0; i < 2; ++i) { *(v4u*)((sp) + kl0 + i * 32 * KROW) = rk[i]; *(v2u*)((sp) + vl0 + i * 64 * VROW) = (v2u){rv[i].x, rv[i].y}; *(v2u*)((sp) + vl0 + i * 64 * VROW + 16) = (v2u){rv[i].z, rv[i].w}; } } while (0)
    DA_LOAD(0);
    const bf16* qp = QKV + (tokbase + 128 * qb + 32 * qg + q32) * NIN + QD + h * 128 + c * 64 + 8 * hi;
    bf16x8 qf[4];
#pragma unroll
    for (int d0 = 0; d0 < 4; ++d0) qf[d0] = *(const bf16x8*)(qp + 16 * d0);
    DA_STORE(lds);
    __syncthreads();
    f32x16 o[4];
#pragma unroll
    for (int j = 0; j < 4; ++j)
#pragma unroll
        for (int r = 0; r < 16; ++r) o[j][r] = 0.f;
    constexpr float THR = 8.f;
    float mref = 0.f, l = 0.f; f32x16 negm;
#pragma unroll
    for (int r = 0; r < 16; ++r) negm[r] = 0.f;
    bf16x8 pb[4];
#define DA_QKSM(soff) do { const unsigned char* kp = lds + (soff) + q32 * KROW + c * 128 + hi * 16; f32x16 p0, p1; \
        __builtin_amdgcn_s_setprio(1); \
        _Pragma("unroll") for (int d0 = 0; d0 < 4; ++d0) { const bf16x8 k0 = *(const bf16x8*)(kp + d0 * 32), k1 = *(const bf16x8*)(kp + 32 * KROW + d0 * 32); \
            if (d0 == 0) { p0 = __builtin_amdgcn_mfma_f32_32x32x16_bf16(k0, qf[0], negm, 0, 0, 0); p1 = __builtin_amdgcn_mfma_f32_32x32x16_bf16(k1, qf[0], negm, 0, 0, 0); } \
            else { p0 = __builtin_amdgcn_mfma_f32_32x32x16_bf16(k0, qf[d0], p0, 0, 0, 0); p1 = __builtin_amdgcn_mfma_f32_32x32x16_bf16(k1, qf[d0], p1, 0, 0, 0); } } \
        __builtin_amdgcn_s_setprio(0); \
        float mt = fmaxf(p0[0], p1[0]); \
        _Pragma("unroll") for (int r = 1; r < 16; ++r) mt = fmaxf(mt, fmaxf(p0[r], p1[r])); \
        mt = half_max(mt); \
        if (t == 0 || __any(mt > THR)) { const float dl = (t == 0) ? mt : fmaxf(mt, 0.f); mref += dl; \
            _Pragma("unroll") for (int r = 0; r < 16; ++r) { p0[r] -= dl; p1[r] -= dl; negm[r] = -mref; } \
            const float f = __builtin_amdgcn_exp2f(-dl); l *= f; \
            _Pragma("unroll") for (int j = 0; j < 4; ++j) _Pragma("unroll") for (int r = 0; r < 16; ++r) o[j][r] *= f; } \
        float ps = 0.f; \
        _Pragma("unroll") for (int r = 0; r < 16; ++r) { p0[r] = __builtin_amdgcn_exp2f(p0[r]); p1[r] = __builtin_amdgcn_exp2f(p1[r]); ps += p0[r] + p1[r]; } \
        l += ps; \
        _Pragma("unroll") for (int kk = 0; kk < 4; ++kk) { v4u w; \
            if (kk < 2) { w.x = pkbf(p0[8 * kk + 0], p0[8 * kk + 1]); w.y = pkbf(p0[8 * kk + 2], p0[8 * kk + 3]); w.z = pkbf(p0[8 * kk + 4], p0[8 * kk + 5]); w.w = pkbf(p0[8 * kk + 6], p0[8 * kk + 7]); } \
            else { const int k2 = kk - 2; w.x = pkbf(p1[8 * k2 + 0], p1[8 * k2 + 1]); w.y = pkbf(p1[8 * k2 + 2], p1[8 * k2 + 3]); w.z = pkbf(p1[8 * k2 + 4], p1[8 * k2 + 5]); w.w = pkbf(p1[8 * k2 + 6], p1[8 * k2 + 7]); } \
            pb[kk] = __builtin_bit_cast(bf16x8, w); } } while (0)
#define DA_PV(soff) do { const unsigned char* vp = lds + (soff) + KBYTES + q32 * VROW + hi * 16; \
        __builtin_amdgcn_s_setprio(1); \
        _Pragma("unroll") for (int j = 0; j < 4; ++j) _Pragma("unroll") for (int kk = 0; kk < 4; ++kk) { const bf16x8 vf = *(const bf16x8*)(vp + j * 32 * VROW + kk * 32); o[j] = __builtin_amdgcn_mfma_f32_32x32x16_bf16(vf, pb[kk], o[j], 0, 0, 0); } \
        __builtin_amdgcn_s_setprio(0); } while (0)
    int s_prev = 2 * STAGE, s_cur = 0, s_nxt = STAGE;
    for (int t = 0; t < NT; ++t) {
        const bool more = (t + 1 < NT);
        if (more) DA_LOAD(t + 1);
        if (c == 1 && t >= 1 && t - 1 <= myT) DA_PV(s_prev);
        if (t <= myT) DA_QKSM(s_cur);
        if (c == 0 && t <= myT) DA_PV(s_cur);
        if (more) DA_STORE(lds + s_nxt);
        __syncthreads();
        { const int tmp = s_prev; s_prev = s_cur; s_cur = s_nxt; s_nxt = tmp; }
    }
    if (c == 1 && myT == NT - 1) DA_PV(s_prev);
    __syncthreads();
#undef DA_QKSM
#undef DA_PV
#undef DA_LOAD
#undef DA_STORE
    l = half_sum(l);
    float* xch = (float*)(lds + qg * XCH);
    if (c == 1) { const float f = lam / l;
#pragma unroll
        for (int j = 0; j < 4; ++j)
#pragma unroll
            for (int r = 0; r < 16; ++r) xch[(32 * j + crow(r, hi)) * 32 + q32] = o[j][r] * f; }
    __syncthreads();
    if (c == 0) { const float il = 1.f / l; float ss = 0.f;
#pragma unroll
        for (int j = 0; j < 4; ++j)
#pragma unroll
            for (int r = 0; r < 16; ++r) { const float v = o[j][r] * il - xch[(32 * j + crow(r, hi)) * 32 + q32]; o[j][r] = v; ss += v * v; }
        ss = half_sum(ss);
        const float rr = 1.f / sqrtf(ss * (1.f / 128.f) + LN_EPS);
        const float* ngs = (const float*)(lds + NG_OFF);
        unsigned char* stg = lds + STG_OFF + qg * STG_BYTES;
#pragma unroll
        for (int j = 0; j < 4; ++j)
#pragma unroll
            for (int r4 = 0; r4 < 4; ++r4) { const int dv0 = 32 * j + 8 * r4 + 4 * hi; const f32x4 gv = *(const f32x4*)(ngs + dv0);
                v2u w; w.x = pkbf(o[j][4 * r4 + 0] * rr * gv.x, o[j][4 * r4 + 1] * rr * gv.y); w.y = pkbf(o[j][4 * r4 + 2] * rr * gv.z, o[j][4 * r4 + 3] * rr * gv.w);
                *(v2u*)(stg + q32 * 272 + dv0 * 2) = w; }
        asm volatile("s_waitcnt lgkmcnt(0)" ::: "memory");
        bf16* orow = MIX + (tokbase + 128 * qb + 32 * qg) * D + h * 128;
#pragma unroll
        for (int i = 0; i < 8; ++i) { const int idx = lane + 64 * i, row = idx >> 4, pc = idx & 15; const v4u v = *(const v4u*)(stg + row * 272 + pc * 16); *(v4u*)(orow + (size_t)row * D + pc * 8) = v; }
    }
    __syncthreads();
}
__device__ __forceinline__ void da_phase(const bf16* QKV, const bf16* VT, bf16* MIX, const float* ng, float lam, unsigned char* lds, int bx, int G, int tid, int lane, int wave) {
    if (tid < 128) ((float*)(lds + NG_OFF))[tid] = ng[tid] * (1.f - LAMBDA_INIT);
    __syncthreads();
    if (G == 256) { const int v = (bx & 7) * 32 + (bx >> 3), bh = v >> 3, s = v & 7;
        for (int i = 0; i < 4; ++i) { const int qb = (i == 0) ? 31 - s : (i == 1) ? s : (i == 2) ? 23 - s : 8 + s; da_unit(bh >> 2, bh & 3, qb, QKV, VT, MIX, lds, lam, tid, lane, wave); }
    } else { for (int it = bx; it < 1024; it += G) da_unit((it >> 5) >> 2, (it >> 5) & 3, it & 31, QKV, VT, MIX, lds, lam, tid, lane, wave); }
}
}
namespace xa {
typedef short bf16x8 __attribute__((ext_vector_type(8)));
typedef float f32x16 __attribute__((ext_vector_type(16)));
constexpr int ROW = 144, STAGE = 256 * ROW, OSTG = 32 * 272;
__device__ __forceinline__ void xa_unit(int b, int hd, int qb, const bf16* __restrict__ QC, const bf16* __restrict__ KC, const bf16* __restrict__ VCT, bf16* __restrict__ OC, unsigned char* lds, int tid, int lane, int wave) {
    const int q32 = lane & 31, hi = lane >> 5;
    const size_t tok0 = (size_t)b * SEQ + 256 * qb + 32 * wave;
    const int r0 = tid >> 3, pc = tid & 7;
    const char* kbase = (const char*)(KC + (size_t)(b * MEM) * D + hd * 256);
    const char* vbase = (const char*)(VCT + (size_t)(hd * 256) * TM + b * MEM);
    const char* qbase = (const char*)(QC + tok0 * D + hd * 256);
    const unsigned kvo_ = (unsigned)(r0 * D + pc * 8) * 2u, vvo_ = (unsigned)(r0 * TM + pc * 8) * 2u, qvo_ = (unsigned)(q32 * D + 8 * hi) * 2u;
    unsigned kvo = kvo_, vvo = vvo_, qvo = qvo_;
    const int kl0 = r0 * ROW + pc * 16, vl0 = r0 * ROW + (pc >> 1) * 32 + (pc & 1) * 8;
#define XA_KLD(i, ch) (*(const v4u*)(kbase + (size_t)((i) * 64 * D + (ch) * 64) * 2 + kvo))
#define XA_VLD(i, hf, ch) (*(const v4u*)(vbase + (size_t)(((hf) * 128 + (i) * 64) * TM + (ch) * 64) * 2 + vvo))
#define XA_QLD(ch, d0) (*(const bf16x8*)(qbase + (size_t)((ch) * 64 + 16 * (d0)) * 2 + qvo))
    v4u rg[4];
#pragma unroll
    for (int i = 0; i < 4; ++i) rg[i] = XA_KLD(i, 0);
    bf16x8 qf[4];
#pragma unroll
    for (int d0 = 0; d0 < 4; ++d0) qf[d0] = XA_QLD(0, d0);
#pragma unroll
    for (int i = 0; i < 4; ++i) *(v4u*)(lds + kl0 + i * 64 * ROW) = rg[i];
    __syncthreads();
    f32x16 p[8], o[4]; bf16x8 pb[16]; float l = 0.f;
#pragma unroll
    for (int kb = 0; kb < 8; ++kb)
#pragma unroll
        for (int r = 0; r < 16; ++r) p[kb][r] = 0.f;
#pragma unroll
    for (int s = 0; s < 12; ++s) {
        kvo = kvo_; vvo = vvo_; qvo = qvo_; asm volatile("" : "+v"(kvo), "+v"(vvo), "+v"(qvo));
        if (s + 1 < 4) {
#pragma unroll
            for (int i = 0; i < 4; ++i) rg[i] = XA_KLD(i, s + 1);
        } else if (s + 1 < 12) { const int hn = (s + 1 - 4) >> 2, kn = (s + 1 - 4) & 3;
#pragma unroll
            for (int i = 0; i < 2; ++i) rg[i] = XA_VLD(i, hn, kn);
        }
        const unsigned char* cur = lds + (s & 1) * STAGE + q32 * ROW + hi * 16;
        if (s < 4) {
#pragma unroll
            for (int kb = 0; kb < 8; ++kb)
#pragma unroll
                for (int d0 = 0; d0 < 4; ++d0) { const bf16x8 kf = *(const bf16x8*)(cur + kb * 32 * ROW + d0 * 32); p[kb] = __builtin_amdgcn_mfma_f32_32x32x16_bf16(kf, qf[d0], p[kb], 0, 0, 0); if (d0 == 3 && (kb & 1)) __builtin_amdgcn_sched_barrier(0); }
            if (s + 1 < 4) {
#pragma unroll
                for (int d0 = 0; d0 < 4; ++d0) qf[d0] = XA_QLD(s + 1, d0);
            }
            if (s == 3) {
                float mt = p[0][0];
#pragma unroll
                for (int kb = 0; kb < 8; ++kb)
#pragma unroll
                    for (int r = 0; r < 16; ++r) mt = fmaxf(mt, p[kb][r]);
                mt = half_max(mt);
#pragma unroll
                for (int kb = 0; kb < 8; ++kb) {
#pragma unroll
                    for (int r = 0; r < 16; ++r) { p[kb][r] = __builtin_amdgcn_exp2f(p[kb][r] - mt); l += p[kb][r]; }
#pragma unroll
                    for (int hh = 0; hh < 2; ++hh) { v4u w; w.x = da::pkbf(p[kb][8 * hh + 0], p[kb][8 * hh + 1]); w.y = da::pkbf(p[kb][8 * hh + 2], p[kb][8 * hh + 3]); w.z = da::pkbf(p[kb][8 * hh + 4], p[kb][8 * hh + 5]); w.w = da::pkbf(p[kb][8 * hh + 6], p[kb][8 * hh + 7]);
                        pb[2 * kb + hh] = __builtin_bit_cast(bf16x8, w); } }
                l = half_sum(l);
            }
        } else {
            const int half = (s - 4) >> 2, kc = (s - 4) & 3;
            if (kc == 0) {
#pragma unroll
                for (int j = 0; j < 4; ++j)
#pragma unroll
                    for (int r = 0; r < 16; ++r) o[j][r] = 0.f;
            }
#pragma unroll
            for (int j = 0; j < 4; ++j)
#pragma unroll
                for (int kk = 0; kk < 4; ++kk) { const bf16x8 vf = *(const bf16x8*)(cur + j * 32 * ROW + kk * 32); o[j] = __builtin_amdgcn_mfma_f32_32x32x16_bf16(vf, pb[4 * kc + kk], o[j], 0, 0, 0); if (kk == 3 && (j & 1)) __builtin_amdgcn_sched_barrier(0); }
            if (kc == 3) {
                const float il = 1.f / l;
                unsigned char* stg = lds + 2 * STAGE + wave * OSTG;
#pragma unroll
                for (int j = 0; j < 4; ++j)
#pragma unroll
                    for (int r4 = 0; r4 < 4; ++r4) { const int dv0 = 32 * j + 8 * r4 + 4 * hi;
                        v2u w; w.x = da::pkbf(o[j][4 * r4 + 0] * il, o[j][4 * r4 + 1] * il); w.y = da::pkbf(o[j][4 * r4 + 2] * il, o[j][4 * r4 + 3] * il);
                        *(v2u*)(stg + q32 * 272 + dv0 * 2) = w; }
                asm volatile("s_waitcnt lgkmcnt(0)" ::: "memory");
                bf16* orow = OC + tok0 * D + hd * 256 + half * 128;
#pragma unroll
                for (int i = 0; i < 8; ++i) { const int idx = lane + 64 * i, row = idx >> 4, pq = idx & 15; const v4u v = *(const v4u*)(stg + row * 272 + pq * 16); *(v4u*)(orow + (size_t)row * D + pq * 8) = v; }
                asm volatile("s_waitcnt lgkmcnt(0)" ::: "memory");
            }
        }
        if (s + 1 < 12) { unsigned char* sn = lds + ((s + 1) & 1) * STAGE;
            if (s + 1 < 4) {
#pragma unroll
                for (int i = 0; i < 4; ++i) *(v4u*)(sn + kl0 + i * 64 * ROW) = rg[i];
            } else {
#pragma unroll
                for (int i = 0; i < 2; ++i) { *(v2u*)(sn + vl0 + i * 64 * ROW) = (v2u){rg[i].x, rg[i].y}; *(v2u*)(sn + vl0 + i * 64 * ROW + 16) = (v2u){rg[i].z, rg[i].w}; }
            } }
        __syncthreads();
    }
}
__device__ __forceinline__ void xa_phase(const bf16* QC, const bf16* KC, const bf16* VCT, bf16* OC, unsigned char* lds, int bx, int G, int tid, int lane, int wave) {
    const int v = (G % 8 == 0) ? (bx & 7) * (G / 8) + (bx >> 3) : bx;
    for (int u = v * 2; u < 512; u += 2 * G) {
#pragma unroll 1
        for (int i = 0; i < 2; ++i) { const int uu = u + i, bh = uu >> 4; xa_unit(bh >> 2, bh & 3, uu & 15, QC, KC, VCT, OC, lds, tid, lane, wave); } }
}
}
namespace gla {
typedef short bf16x8 __attribute__((ext_vector_type(8)));
typedef float f32x16 __attribute__((ext_vector_type(16)));
constexpr int ROW = 144;
__device__ __forceinline__ float fast_exp(float x) { return __builtin_amdgcn_exp2f(x * LOG2E); }
__device__ __forceinline__ float log_sigmoid(float z) { return fminf(z, 0.f) - 0.6931471805599453f * __builtin_amdgcn_logf(1.f + fast_exp(-fabsf(z))); }
__device__ __forceinline__ void step1(const bf16* __restrict__ QKV, const float* __restrict__ W2, const float* __restrict__ bg, bf16* __restrict__ DS, float* __restrict__ DEC, unsigned char* lds, int bx, int G, int tid, int lane, int wave) {
    unsigned char* vT = lds;
    unsigned char* keT = lds + 128 * ROW;
    const int q32 = lane & 31, hi = lane >> 5;
    v4u nv0, nv1, ng0, ng1, nkk;
#define GLA1_LOAD(it_) do { const int h_ = (it_) & 3; const bf16* row_ = QKV + (size_t)(((it_) >> 2) * 64 + lane) * NIN; \
        nv0 = *(const v4u*)(row_ + VG + h_ * 128 + wave * 8); nv1 = *(const v4u*)(row_ + VG + h_ * 128 + (wave + 8) * 8); ng0 = *(const v4u*)(row_ + GL); ng1 = *(const v4u*)(row_ + GL + 8); nkk = *(const v4u*)(row_ + KG + h_ * 64 + wave * 8); } while (0)
    if (bx < BATCH * 64 * 4) GLA1_LOAD(bx);
    for (int item = bx; item < BATCH * 64 * 4; item += G) {
        const int h = item & 3;
        const v4u v0 = nv0, v1 = nv1, g0 = ng0, g1 = ng1, kk = nkk;
        if (item + G < BATCH * 64 * 4) GLA1_LOAD(item + G);
#pragma unroll
        for (int i = 0; i < 2; ++i) { const v4u vv = i ? v1 : v0; unsigned char* d = vT + ((wave + 8 * i) * 8) * ROW + lane * 2;
            *(bf16*)(d + 0 * ROW) = (bf16)(vv.x & 0xffffu); *(bf16*)(d + 1 * ROW) = (bf16)(vv.x >> 16); *(bf16*)(d + 2 * ROW) = (bf16)(vv.y & 0xffffu); *(bf16*)(d + 3 * ROW) = (bf16)(vv.y >> 16);
            *(bf16*)(d + 4 * ROW) = (bf16)(vv.z & 0xffffu); *(bf16*)(d + 5 * ROW) = (bf16)(vv.z >> 16); *(bf16*)(d + 6 * ROW) = (bf16)(vv.w & 0xffffu); *(bf16*)(d + 7 * ROW) = (bf16)(vv.w >> 16); }
        const float gl[16] = {bflo(g0.x), bfhi(g0.x), bflo(g0.y), bfhi(g0.y), bflo(g0.z), bfhi(g0.z), bflo(g0.w), bfhi(g0.w), bflo(g1.x), bfhi(g1.x), bflo(g1.y), bfhi(g1.y), bflo(g1.z), bfhi(g1.z), bflo(g1.w), bfhi(g1.w)};
        const float kf[8] = {bflo(kk.x), bfhi(kk.x), bflo(kk.y), bfhi(kk.y), bflo(kk.z), bfhi(kk.z), bflo(kk.w), bfhi(kk.w)};
        const float* w2 = W2 + h * 64 + wave * 8;
        float cum[8];
#pragma unroll
        for (int j = 0; j < 8; ++j) { float z = bg[h * 64 + wave * 8 + j];
#pragma unroll
            for (int r = 0; r < 16; ++r) z += gl[r] * w2[r * 256 + j];
            cum[j] = log_sigmoid(z) * (1.f / 16.f); }
#pragma unroll
        for (int off = 1; off < 64; off <<= 1) { const int src = ((lane - off) & 63) << 2;
#pragma unroll
            for (int j = 0; j < 8; ++j) { const float t = __int_as_float(__builtin_amdgcn_ds_bpermute(src, __float_as_int(cum[j]))); if (lane >= off) cum[j] += t; } }
#pragma unroll
        for (int j = 0; j < 8; ++j) { const float tot = __int_as_float(__builtin_amdgcn_readlane(__float_as_int(cum[j]), 63));
            const float ke = kf[j] * fast_exp(tot - cum[j]);
            *(bf16*)(keT + (wave * 8 + j) * ROW + lane * 2) = (bf16)f2bf(ke);
            if (lane == 0) DEC[(size_t)item * 64 + wave * 8 + j] = fast_exp(tot); }
        __syncthreads();
        { const int dvb = wave & 3, dkb = wave >> 2;
            const unsigned char* ap = keT + (32 * dkb + q32) * ROW + hi * 16; const unsigned char* bp = vT + (32 * dvb + q32) * ROW + hi * 16;
            f32x16 acc;
#pragma unroll
            for (int r = 0; r < 16; ++r) acc[r] = 0.f;
#pragma unroll
            for (int ks = 0; ks < 4; ++ks) acc = __builtin_amdgcn_mfma_f32_32x32x16_bf16(*(const bf16x8*)(ap + ks * 32), *(const bf16x8*)(bp + ks * 32), acc, 0, 0, 0);
            bf16* ds = DS + (size_t)item * 8192 + (32 * dvb + q32) * 64 + 32 * dkb + 4 * hi;
#pragma unroll
            for (int r4 = 0; r4 < 4; ++r4) { v2u w; w.x = da::pkbf(acc[4 * r4 + 0], acc[4 * r4 + 1]); w.y = da::pkbf(acc[4 * r4 + 2], acc[4 * r4 + 3]); *(v2u*)(ds + 8 * r4) = w; } }
        __syncthreads();
    }
}
__device__ __forceinline__ void scan(bf16* __restrict__ DS, const float* __restrict__ DEC, int gt, int NGT) {
    for (int p = gt; p < BATCH * 4 * 4096; p += NGT) {
        const int e = 2 * p, bh = e >> 13, rem = e & 8191, b = bh >> 2, h = bh & 3, dk = rem & 63;
        float s0 = 0.f, s1 = 0.f;
#pragma unroll 8
        for (int c = 0; c < 64; ++c) { const size_t item = (size_t)((b * 64 + c) * 4 + h);
            const unsigned d = *(const unsigned*)(DS + item * 8192 + rem); const float dc0 = DEC[item * 64 + dk], dc1 = DEC[item * 64 + dk + 1];
            s0 = dc0 * s0 + bflo(d); s1 = dc1 * s1 + bfhi(d);
            *(unsigned*)(DS + item * 8192 + rem) = da::pkbf(s0, s1); }
    }
}
__device__ __forceinline__ void step3(const bf16* __restrict__ QKV, const bf16* __restrict__ DS, const float* __restrict__ ng, bf16* __restrict__ MIX, unsigned char* lds, int bx, int G, int tid, int lane, int wave) {
    const int q32 = lane & 31, hi = lane >> 5;
    for (int it = bx; it < BATCH * 64; it += G) {
        const int tok0 = it * 64;
        const bf16* ds = DS + (size_t)it * 4 * 8192;
        const int h = wave >> 1, sb = wave & 1; const size_t tok = (size_t)tok0 + 32 * sb + q32;
        const bf16* qrow = QKV + tok * NIN + QG + h * 64 + 8 * hi;
        bf16x8 qf[4];
#pragma unroll
        for (int ks = 0; ks < 4; ++ks) qf[ks] = *(const bf16x8*)(qrow + 16 * ks);
#pragma unroll 4
        for (int i = 0; i < 8; ++i) { const int idx = tid + 512 * i, itl = idx >> 10, f = idx & 1023; const v4u v = *(const v4u*)(ds + 8 * idx);
            *(v4u*)(lds + itl * (128 * ROW) + (f >> 3) * ROW + (f & 7) * 16) = v; }
        __syncthreads();
        const unsigned char* ap = lds + h * (128 * ROW) + q32 * ROW + hi * 16;
        f32x16 o[4];
#pragma unroll
        for (int j = 0; j < 4; ++j) {
#pragma unroll
            for (int r = 0; r < 16; ++r) o[j][r] = 0.f;
#pragma unroll
            for (int ks = 0; ks < 4; ++ks) o[j] = __builtin_amdgcn_mfma_f32_32x32x16_bf16(*(const bf16x8*)(ap + j * 32 * ROW + ks * 32), qf[ks], o[j], 0, 0, 0); }
        float ss = 0.f;
#pragma unroll
        for (int j = 0; j < 4; ++j)
#pragma unroll
            for (int r = 0; r < 16; ++r) { o[j][r] *= 0.125f; ss += o[j][r] * o[j][r]; }
        ss = half_sum(ss);
        const float rr = 1.f / sqrtf(ss * (1.f / 128.f) + LN_EPS);
        const bf16* rrow = QKV + tok * NIN + RG + h * 128; bf16* orow = MIX + tok * D + 512 + h * 128;
#pragma unroll
        for (int j = 0; j < 4; ++j)
#pragma unroll
            for (int r4 = 0; r4 < 4; ++r4) { const int dv0 = 32 * j + 8 * r4 + 4 * hi; const f32x4 gv = *(const f32x4*)(ng + dv0); const v2u rg = *(const v2u*)(rrow + dv0);
                v2u w; w.x = da::pkbf(o[j][4 * r4 + 0] * rr * gv.x * pg8::silu_f(bflo(rg.x)), o[j][4 * r4 + 1] * rr * gv.y * pg8::silu_f(bfhi(rg.x)));
                w.y = da::pkbf(o[j][4 * r4 + 2] * rr * gv.z * pg8::silu_f(bflo(rg.y)), o[j][4 * r4 + 3] * rr * gv.w * pg8::silu_f(bfhi(rg.y)));
                *(v2u*)(orow + dv0) = w; if (r4 == 3) asm volatile("" ::: "memory"); }
        __syncthreads();
    }
}
}
#define XB_TMO      128
#define XB_XCNT(j)  (256  + 64 * (j))
#define XB_XSUB(j)  (1280 + 64 * (j))
#define XB_XGEN(j)  (2304 + 64 * (j))
#define XB_TOP      3328
#define XB_TOPGEN   3392
#define XCD_BAR_WORDS 3456
#define XB_SPIN_CAP (1u << 18)

__device__ __forceinline__ unsigned xb_ld(unsigned* p)              { return __hip_atomic_load(p, __ATOMIC_RELAXED, __HIP_MEMORY_SCOPE_AGENT); }
__device__ __forceinline__ unsigned xb_add(unsigned* p, unsigned v) { return __hip_atomic_fetch_add(p, v, __ATOMIC_RELAXED, __HIP_MEMORY_SCOPE_AGENT); }
__device__ __forceinline__ unsigned xb_xcc_id() { return (unsigned)__builtin_amdgcn_s_getreg((3 << 11) | 20) & 0xFu; }
#define XB_SPIN(cond, bar) do { unsigned _sp = 0; while (cond) { __builtin_amdgcn_s_sleep(1); \
    if ((++_sp & 255u) == 0u) { if (xb_ld(&(bar)[XB_TMO])) break; if (_sp > XB_SPIN_CAP) { atomicAdd(&(bar)[XB_TMO], 1u); break; } } } } while (0)

struct XcdBarrier {
    unsigned* bar; unsigned x;
    volatile LAS unsigned* st;
};

__device__ __forceinline__ XcdBarrier xcd_barrier_post(unsigned* bar, volatile LAS unsigned* st) {
    XcdBarrier b; b.bar = bar; b.x = xb_xcc_id(); b.st = st;
    if (threadIdx.x == 0) (void)xb_add(&bar[XB_XCNT(b.x)], 1u);
    return b;
}
__device__ __forceinline__ void xcd_barrier_complete(unsigned* bar, unsigned x, unsigned& nloc, unsigned& nx) {
    const unsigned G = gridDim.x * gridDim.y * gridDim.z;
    unsigned sum, cnt, mine, sp = 0u;
    for (;;) {
        sum = 0u; cnt = 0u; mine = 0u;
#pragma unroll
        for (unsigned j = 0; j < 16; ++j) { const unsigned c = xb_ld(&bar[XB_XCNT(j)]); sum += c; cnt += (c > 0u) ? 1u : 0u; mine = (j == x) ? c : mine; }
        if (sum == G) break;
        __builtin_amdgcn_s_sleep(1);
        if ((++sp & 255u) == 0u) { if (xb_ld(&bar[XB_TMO])) break; if (sp > XB_SPIN_CAP) { atomicAdd(&bar[XB_TMO], 1u); break; } }
    }
    nloc = mine > 0u ? mine : 1u; nx = cnt > 0u ? cnt : 1u;
}

__device__ __forceinline__ void xcd_barrier(const XcdBarrier& b) {
    asm volatile("s_waitcnt vmcnt(0)" ::: "memory");
    __syncthreads();
    if (threadIdx.x == 0) {
        unsigned* bar = b.bar;
        __builtin_amdgcn_s_waitcnt(0);
        unsigned nloc = b.st[0], nx = b.st[1];
        if (nloc == 0u) { xcd_barrier_complete(bar, b.x, nloc, nx); b.st[0] = nloc; b.st[1] = nx; }
        const unsigned old = xb_add(&bar[XB_XSUB(b.x)], 1u);
        const unsigned gen = old / nloc;
        if (old + 1u == (gen + 1u) * nloc) {
            __builtin_amdgcn_fence(__ATOMIC_RELEASE, "agent");
            asm volatile("s_waitcnt vmcnt(0)" ::: "memory");
            const unsigned og = xb_add(&bar[XB_TOP], 1u);
            const unsigned tg = og / nx;
            if (og + 1u == (tg + 1u) * nx) xb_add(&bar[XB_TOPGEN], 1u);
            else XB_SPIN(xb_ld(&bar[XB_TOPGEN]) == tg, bar);
            __builtin_amdgcn_fence(__ATOMIC_ACQUIRE, "agent");
            xb_add(&bar[XB_XGEN(b.x)], 1u);
            asm volatile("s_waitcnt vmcnt(0)" ::: "memory");
        } else {
            XB_SPIN(xb_ld(&bar[XB_XGEN(b.x)]) == gen, bar);
            __builtin_amdgcn_fence(__ATOMIC_ACQUIRE, "agent");
            asm volatile("s_waitcnt vmcnt(0)" ::: "memory");
        }
    }
    __syncthreads();
}

struct Args { const float* in[29]; float* out; unsigned char* ws; };
#define GEMM_PHASE(EPI, Aptr, Bptr, M_, N_, K_, Eobj) GEMM_PHASE_R(EPI, Aptr, Bptr, M_, N_, K_, Eobj, 0)
#define GEMM_PHASE_S(EPI, Aptr, Bptr, M_, N_, K_, Eobj, PSTp, BYPN, CSp, BWp) do { pg8::Gemm g_{(const pg8::bf16_t*)(Aptr), (const pg8::bf16_t*)(Bptr), (M_), (N_), (K_)}; pg8::StatsOrder S_; S_.init((M_), (N_), G, bx); S_.PST = (PSTp); S_.sbuf = ldsp + 139264; S_.by_pn = (BYPN); S_.cs = (CSp); S_.bw = (BWp); S_.cbuf = ldsp + 131072; S_.k = 0; \
    pg8::gemm_phase<EPI, pg8::StatsOrder, true, true>(ldsp, g_, S_, Eobj); } while (0)
#define GEMM_PHASE_R(EPI, Aptr, Bptr, M_, N_, K_, Eobj, ROT) do { pg8::Gemm g_{(const pg8::bf16_t*)(Aptr), (const pg8::bf16_t*)(Bptr), (M_), (N_), (K_)}; pg8::StaticOrder S_; S_.init((M_), (N_), G, (bx + (ROT)) % G); \
    pg8::gemm_phase<EPI, pg8::StaticOrder, true, true>(ldsp, g_, S_, Eobj); } while (0)

#ifndef REP_P0
#define REP_P0 1
#endif
#ifndef REP_GU
#define REP_GU 1
#endif
#ifndef REP_LN
#define REP_LN 1
#endif
#ifndef REP_WIN
#define REP_WIN 1
#endif
#ifndef REP_GLA1
#define REP_GLA1 1
#endif
#ifndef REP_DA
#define REP_DA 1
#endif
#ifndef REP_GLA3
#define REP_GLA3 1
#endif
#ifndef REP_WQ
#define REP_WQ 1
#endif
#ifndef REP_XA
#define REP_XA 1
#endif
#define REP(n) _Pragma("unroll 1") for (int rep_ = 0; rep_ < (n); ++rep_)
__global__ void __launch_bounds__(512, 2) mk_fwd(Args a) {
    extern __shared__ __attribute__((aligned(16))) unsigned char lds[];
    cg::grid_group grid = cg::this_grid();
    LAS unsigned char* ldsp = (LAS unsigned char*)lds;
    const int G = gridDim.x, bx = blockIdx.x, NGW = G * 8; const size_t NGT = (size_t)G * 512;
#define TIDS() int tid = threadIdx.x; asm volatile("" : "+v"(tid)); const int lane = tid & 63, wave = __builtin_amdgcn_readfirstlane(tid >> 6), gw = bx * 8 + wave; const size_t gt = (size_t)bx * 512 + tid; (void)lane; (void)gw; (void)gt;
    unsigned char* ws = a.ws;
    volatile LAS unsigned* bst = (volatile LAS unsigned*)(ldsp + LDS_BYTES - 64);
    if (threadIdx.x < 2) bst[threadIdx.x] = 0u;
    __syncthreads();
    const XcdBarrier bar = xcd_barrier_post((unsigned*)(ws + WS_CTL), bst);
    bf16 *Wgu1 = (bf16*)(ws + WS_GU1), *Wd1 = (bf16*)(ws + WS_D1), *Win = (bf16*)(ws + WS_WIN), *Wout = (bf16*)(ws + WS_WOUT), *Wq = (bf16*)(ws + WS_WQ), *Wkv = (bf16*)(ws + WS_WKV), *Wo = (bf16*)(ws + WS_WO),
         *Wgu2 = (bf16*)(ws + WS_GU2), *Wd2 = (bf16*)(ws + WS_D2), *MB = (bf16*)(ws + WS_MB), *KC = (bf16*)(ws + WS_KVC), *VCT = (bf16*)(ws + WS_KVC + 4 * MiB), *XB = (bf16*)(ws + WS_XB), *MIX = XB, *HB = (bf16*)(ws + WS_HB),
         *Hh = (bf16*)(ws + WS_R1), *QKV = Hh, *QC = Hh, *OC = (bf16*)(ws + WS_R1 + 64 * MiB), *VT = (bf16*)(ws + WS_VT);
    float *PSTA = (float*)(ws + WS_PSTA), *PSTB = (float*)(ws + WS_PSTB), *PARTC = (float*)(ws + WS_PARTC), *PARTB = (float*)(ws + WS_PARTB), *CS = (float*)(ws + WS_CS), *BW = (float*)(ws + WS_BW);
    PG8_LAS float* red = (PG8_LAS float*)(ldsp + 131072); const PG8_LAS float* sbl = (const PG8_LAS float*)(ldsp + 139264); const PG8_LAS float* cbl = (const PG8_LAS float*)(ldsp + 131072);
    float *stats = (float*)(ws + WS_STATS), *DEC = (float*)(ws + WS_DEC), *V = a.out; bf16* DS = (bf16*)(ws + WS_DS);

    REP(REP_P0) {   TIDS();
        float* scr = (float*)(lds + wave * 16640);
        transpose_matrix<1, false>(a.in[2], D, FH, Wgu1, scr, gw, NGW, lane);
        transpose_matrix<2, false>(a.in[3], D, FH, Wgu1, scr, gw, NGW, lane);
        transpose_matrix<0, false>(a.in[4], FH, D, Wd1, scr, gw, NGW, lane);
        transpose_matrix<3, true>(a.in[7], D, 3088, Win, scr, gw, NGW, lane, a.in[5], a.in[6], PARTC + WIN_OFF, PARTB + WIN_OFF);
        transpose_matrix<0, false>(a.in[16], D, D, Wout, scr, gw, NGW, lane);
        transpose_matrix<0, true>(a.in[19], D, D, Wq, scr, gw, NGW, lane, a.in[17], a.in[18], PARTC + WQ_OFF, PARTB + WQ_OFF);
        transpose_matrix<0, false>(a.in[20], D, 2 * D, Wkv, scr, gw, NGW, lane);
        transpose_matrix<0, false>(a.in[21], D, D, Wo, scr, gw, NGW, lane);
        transpose_matrix<1, true>(a.in[24], D, FH, Wgu2, scr, gw, NGW, lane, a.in[22], a.in[23], PARTC + GU2_OFF, PARTB + GU2_OFF);
        transpose_matrix<2, true>(a.in[25], D, FH, Wgu2, scr, gw, NGW, lane, a.in[22], a.in[23], PARTC + GU2_OFF, PARTB + GU2_OFF);
        transpose_matrix<0, false>(a.in[26], FH, D, Wd2, scr, gw, NGW, lane);
        for (size_t i = gt; i < (size_t)(NIN - 2624) * D / 8; i += NGT) *(v4u*)(Win + (size_t)2624 * D + 8 * i) = (v4u){0u, 0u, 0u, 0u};
        convert_bf16(a.in[0], XB, (size_t)T * D, gt, NGT);
        convert_bf16(a.in[1], MB, (size_t)TM * D, gt, NGT);
    }
    if (a.ws == nullptr) grid.sync();
    xcd_barrier(bar);
    {   TIDS();
        for (int r = (int)gt; r < PTOT; r += (int)NGT) { float c = 0.f, w = 0.f;
            if (!(r >= 2624 && r < 2816)) {
#pragma unroll
                for (int kb = 0; kb < 16; ++kb) { c += PARTC[(size_t)kb * PTOT + r]; w += PARTB[(size_t)kb * PTOT + r]; } }
            CS[r] = c; BW[r] = w; }
    }
    REP(REP_GU) { pg8::EpiSwiglu E{Hh, FH}; GEMM_PHASE(pg8::EpiSwiglu, XB, Wgu1, T, 2 * FH, D, E); }
    xcd_barrier(bar);
    { typedef pg8::EpiResidS<0, true> EP; EP E{V, XB, sbl, nullptr, nullptr, HB, PSTA, red, D, ALPHA, 0.5f, 0}; GEMM_PHASE(EP, Hh, Wd1, T, D, FH, E); }
    xcd_barrier(bar);
    REP(REP_WIN) { pg8::EpiStoreLn E{QKV, NIN, 2, C2_DA, sbl, cbl, 0}; GEMM_PHASE_S(pg8::EpiStoreLn, HB, Win, T, NIN, D, E, PSTA, 0, CS + WIN_OFF, BW + WIN_OFF); }
    { pg8::EpiStoreLnT E{VT, T, sbl, cbl, 0}; GEMM_PHASE_S(pg8::EpiStoreLnT, Win + (size_t)VDROW * D, HB, 512, T, D, E, PSTA, 1, CS + WIN_OFF + VDROW, BW + WIN_OFF + VDROW); }
    { pg8::EpiStore E{KC, D, 0, 1.f}; GEMM_PHASE_R(pg8::EpiStore, MB, Wkv, TM, D, D, E, 128); }
    { pg8::EpiStore E{VCT, TM, 0, 1.f}; GEMM_PHASE_R(pg8::EpiStore, Wkv + (size_t)D * D, MB, D, TM, D, E, 64); }
    xcd_barrier(bar);
    REP(REP_GLA1) { TIDS(); gla::step1(QKV, a.in[13], a.in[14], DS, DEC, lds, bx, G, tid, lane, wave); }
    xcd_barrier(bar);
    {   TIDS();
        gla::scan(DS, DEC, (int)gt, (int)NGT);
        const float sa = wave_sum(a.in[8][lane] * a.in[9][lane]), sb = wave_sum(a.in[10][lane] * a.in[11][lane]);
        const float lam = expf(sa) - expf(sb) + LAMBDA_INIT;
        REP(REP_DA) da::da_phase(QKV, VT, MIX, a.in[12], lam, lds, bx, G, tid, lane, wave);
    }
    xcd_barrier(bar);
    REP(REP_GLA3) { TIDS(); gla::step3(QKV, DS, a.in[15], MIX, lds, bx, G, tid, lane, wave); }
    xcd_barrier(bar);
    { typedef pg8::EpiResidS<1, true> EP; EP E{V, HB, sbl, a.in[5], a.in[6], HB, PSTB, red, D, ALPHA, 1.f, 0}; GEMM_PHASE_S(EP, MIX, Wout, T, D, D, E, PSTA, 0, nullptr, nullptr); }
    xcd_barrier(bar);
    REP(REP_WQ) { pg8::EpiStoreLn E{QC, D, 4, C2_X, sbl, cbl, 0}; GEMM_PHASE_S(pg8::EpiStoreLn, HB, Wq, T, D, D, E, PSTB, 0, CS + WQ_OFF, BW + WQ_OFF); }
    xcd_barrier(bar);
    REP(REP_XA) { TIDS(); xa::xa_phase(QC, KC, VCT, OC, lds, bx, G, tid, lane, wave); }
    xcd_barrier(bar);
    { typedef pg8::EpiResidS<1, true> EP; EP E{V, HB, sbl, a.in[17], a.in[18], HB, PSTA, red, D, ALPHA, 1.f, 0}; GEMM_PHASE_S(EP, OC, Wo, T, D, D, E, PSTB, 0, nullptr, nullptr); }
    xcd_barrier(bar);
    { pg8::EpiSwigluLn E{Hh, FH, sbl, cbl, 0}; GEMM_PHASE_S(pg8::EpiSwigluLn, HB, Wgu2, T, 2 * FH, D, E, PSTA, 0, CS + GU2_OFF, BW + GU2_OFF); }
    xcd_barrier(bar);
    { typedef pg8::EpiResidS<1, false> EP; EP E{V, HB, sbl, a.in[22], a.in[23], nullptr, nullptr, red, D, ALPHA, 0.5f, 0}; GEMM_PHASE_S(EP, Hh, Wd2, T, D, FH, E, PSTA, 0, nullptr, nullptr); }
    xcd_barrier(bar);
    { TIDS(); ln_pass<true>(V, a.in[27], a.in[28], nullptr, nullptr, gw, NGW, lane); }
}

extern "C" void kernel_launch(void* const* d_in, const int* in_sizes, int n_in, void* d_out, int out_size, void* d_ws, size_t ws_size, hipStream_t stream) {
    static int grid = 0;
    if (grid == 0) {
        if (n_in != 29 || out_size != T * D || ws_size < WS_END) { fprintf(stderr, "kernel_launch: unexpected shapes (n_in %d out %d ws %zu)\n", n_in, out_size, ws_size); grid = -1; return; }
        int dev = 0, cus = 0, per_cu = 0;
        hipGetDevice(&dev); hipDeviceGetAttribute(&cus, hipDeviceAttributeMultiprocessorCount, dev);
        hipFuncSetAttribute((const void*)mk_fwd, hipFuncAttributeMaxDynamicSharedMemorySize, LDS_BYTES);
        if (hipOccupancyMaxActiveBlocksPerMultiprocessor(&per_cu, (const void*)mk_fwd, 512, LDS_BYTES) != hipSuccess || per_cu < 1) per_cu = 1;
        (void)hipGetLastError();
        grid = cus * 1;
    }
    if (grid < 0) return;
    if (hipMemsetAsync((char*)d_ws + WS_CTL, 0, 16384, stream) != hipSuccess) { fprintf(stderr, "kernel_launch: memset failed\n"); return; }
    Args a{};
    for (int i = 0; i < 29; ++i) a.in[i] = (const float*)d_in[i];
    a.out = (float*)d_out; a.ws = (unsigned char*)d_ws;
    void* args[] = {&a};
    hipError_t e = hipLaunchCooperativeKernel((const void*)mk_fwd, dim3(grid), dim3(512), args, LDS_BYTES, stream);
    if (e != hipSuccess) fprintf(stderr, "cooperative launch failed: %s (grid %d)\n", hipGetErrorString(e), grid);
}
```
